# Optimizing an MI355X kernel written in HIP

```python
import jax
import jax.numpy as jnp
from jax import lax
import numpy as np

D_MODEL = 1024
BATCH = 8
SEQ = 2048
DEPTH = 2

CTX_LEN = 256
GRID_W = 64

NA_HEADS = 4
NA_HEAD_DIM = 64
NA_WIN_R = 8
NA_WIN_C = 16

WA_HEADS = 4
WA_KV_HEADS = 2
WA_HEAD_DIM = 64
WA_WINDOW = 128
WA_BLOCK = 128

GLA_HEADS = 4
GLA_DK = 64
GLA_DV = 128
GLA_GATE_RANK = 16
GLA_GATE_TAU = 16.0
GLA_CHUNK = 64

NA_WIDTH = NA_HEADS * NA_HEAD_DIM
WA_Q_WIDTH = WA_HEADS * WA_HEAD_DIM
WA_KV_WIDTH = WA_KV_HEADS * WA_HEAD_DIM
GLA_QK_WIDTH = GLA_HEADS * GLA_DK
GLA_V_WIDTH = GLA_HEADS * GLA_DV
MIX_WIDTH = NA_WIDTH + WA_Q_WIDTH + GLA_V_WIDTH
IN_WIDTH = 3 * NA_WIDTH + WA_Q_WIDTH + 2 * WA_KV_WIDTH + 2 * GLA_QK_WIDTH + 2 * GLA_V_WIDTH + 2 * GLA_GATE_RANK

FF_DIM = 2816
FF_CONV = 3

ROPE_THETA = 10000.0
EPS = 1e-6

kernel_name = 'hybrid_na_swa_gla_dit_trunk'


def rms_norm(x, g):
    xf = x.astype(jnp.float32)
    y = xf * lax.rsqrt(jnp.mean(xf * xf, axis=-1, keepdims=True) + EPS)
    return (y * g.astype(jnp.float32)).astype(x.dtype)


def modulate(x, g, shift, scale):
    return rms_norm(x, g) * (1 + scale) + shift


def split_heads(a, n_heads):
    return a.reshape(a.shape[0], a.shape[1], n_heads, a.shape[2] // n_heads)


def in_split_points():
    widths = (NA_WIDTH, NA_WIDTH, NA_WIDTH, WA_Q_WIDTH, WA_KV_WIDTH, WA_KV_WIDTH,
              GLA_QK_WIDTH, GLA_QK_WIDTH, GLA_V_WIDTH, GLA_V_WIDTH, GLA_GATE_RANK)
    points, acc = [], 0
    for w in widths:
        acc += w
        points.append(acc)
    return points


def mixer_inputs(h, w_in, gate_w, gate_b):
    (na_q, na_k, na_v, wa_q, wa_k, wa_v, g_q, g_k, g_v, g_out, lr_f, lr_b) = jnp.split(
        h @ w_in, in_split_points(), axis=-1)

    def log_decay(lr, d):
        logit = (lr @ gate_w[d] + gate_b[d]).astype(jnp.float32)
        return split_heads(jax.nn.log_sigmoid(logit) / GLA_GATE_TAU, GLA_HEADS)

    return dict(
        na_q=split_heads(na_q, NA_HEADS), na_k=split_heads(na_k, NA_HEADS), na_v=split_heads(na_v, NA_HEADS),
        wa_q=split_heads(wa_q, WA_HEADS), wa_k=split_heads(wa_k, WA_KV_HEADS), wa_v=split_heads(wa_v, WA_KV_HEADS),
        g_q=split_heads(g_q, GLA_HEADS) * GLA_DK ** -0.5, g_k=split_heads(g_k, GLA_HEADS),
        g_v=split_heads(g_v, GLA_HEADS), g_out=g_out,
        la_f=log_decay(lr_f, 0), la_b=log_decay(lr_b, 1))


def axial_rope(n_tokens, head_dim):
    t = jnp.arange(n_tokens)
    row = (t // GRID_W).astype(jnp.float32)
    col = (t % GRID_W).astype(jnp.float32)
    n_freq = head_dim // 4
    inv = ROPE_THETA ** (-jnp.arange(n_freq, dtype=jnp.float32) / n_freq)
    ang = jnp.concatenate([row[:, None] * inv, col[:, None] * inv], axis=-1)
    return jnp.cos(ang), jnp.sin(ang)


def apply_rope(x, cos, sin):
    x1, x2 = jnp.split(x.astype(jnp.float32), 2, axis=-1)
    c, s = cos[:, None, :], sin[:, None, :]
    return jnp.concatenate([x1 * c - x2 * s, x1 * s + x2 * c], axis=-1).astype(x.dtype)


def context_attention(q, k, v, sink=None):
    B, L, H, Dh = q.shape
    Lk, Hkv = k.shape[1], k.shape[2]
    G = H // Hkv
    qg = q.reshape(B, L, Hkv, G, Dh)
    s = jnp.einsum('bqkgd,blkd->bkgql', qg, k).astype(jnp.float32) * Dh ** -0.5
    if sink is not None:
        s_sink = jnp.broadcast_to(sink.astype(jnp.float32).reshape(1, Hkv, G, 1, 1), s.shape[:-1] + (1,))
        s = jnp.concatenate([s, s_sink], axis=-1)
    p = jax.nn.softmax(s, axis=-1)[..., :Lk].astype(v.dtype)
    return jnp.einsum('bkgql,blkd->bqkgd', p, v).reshape(B, L, H, Dh)


def neighbourhood_attention(q, k, v, k_ctx, v_ctx, rpb):
    B, S, H, Dh = q.shape
    rows = S // GRID_W
    win_r = min(NA_WIN_R, rows)
    scale = Dh ** -0.5
    qg = q.reshape(B, rows, GRID_W, H, Dh)
    kg = k.reshape(B, rows, GRID_W, H, Dh)
    vg = v.reshape(B, rows, GRID_W, H, Dh)
    col = jnp.arange(GRID_W)
    col_start = jnp.clip(col - NA_WIN_C // 2, 0, GRID_W - NA_WIN_C)
    col_idx = col_start[:, None] + jnp.arange(NA_WIN_C)[None, :]
    col_off = col_idx - col[:, None] + (NA_WIN_C - 1)
    n_nb = win_r * NA_WIN_C

    def one_row(r):
        rs = jnp.clip(r - win_r // 2, 0, rows - win_r)
        kn = lax.dynamic_slice_in_dim(kg, rs, win_r, axis=1)[:, :, col_idx]
        vn = lax.dynamic_slice_in_dim(vg, rs, win_r, axis=1)[:, :, col_idx]
        qr = lax.dynamic_index_in_dim(qg, r, axis=1, keepdims=False)
        row_off = rs + jnp.arange(win_r) - r + (NA_WIN_R - 1)
        bias = rpb[:, row_off][:, :, col_off].transpose(0, 2, 1, 3).astype(jnp.float32)
        s_nb = jnp.einsum('bqhd,brqjhd->bhqrj', qr, kn).astype(jnp.float32) * scale + bias[None]
        s_ctx = jnp.einsum('bqhd,blhd->bhql', qr, k_ctx).astype(jnp.float32) * scale
        s = jnp.concatenate([s_nb.reshape(B, H, GRID_W, n_nb), s_ctx], axis=-1)
        p = jax.nn.softmax(s, axis=-1).astype(v.dtype)
        p_nb = p[..., :n_nb].reshape(B, H, GRID_W, win_r, NA_WIN_C)
        return (jnp.einsum('bhqrj,brqjhd->bqhd', p_nb, vn)
                + jnp.einsum('bhql,blhd->bqhd', p[..., n_nb:], v_ctx))

    out = lax.map(one_row, jnp.arange(rows))
    return out.transpose(1, 0, 2, 3, 4).reshape(B, S, H, Dh)


def window_attention(q, k, v, k_ctx, v_ctx, sink):
    B, S, H, Dh = q.shape
    Hkv = k.shape[2]
    G = H // Hkv
    nb = S // WA_BLOCK
    n_loc = 3 * WA_BLOCK
    L = k_ctx.shape[1]
    scale = Dh ** -0.5

    def band(a):
        ap = jnp.pad(a, ((0, 0), (WA_BLOCK, WA_BLOCK), (0, 0), (0, 0))).reshape(B, nb + 2, WA_BLOCK, Hkv, Dh)
        return jnp.concatenate([ap[:, :-2], ap[:, 1:-1], ap[:, 2:]], axis=2)

    kb, vb = band(k), band(v)
    qb = q.reshape(B, nb, WA_BLOCK, Hkv, G, Dh)
    s_loc = jnp.einsum('bnqkgd,bnskd->bnkgqs', qb, kb).astype(jnp.float32) * scale
    q_pos = jnp.arange(nb)[:, None] * WA_BLOCK + jnp.arange(WA_BLOCK)[None, :]
    k_pos = jnp.arange(nb)[:, None] * WA_BLOCK - WA_BLOCK + jnp.arange(n_loc)[None, :]
    valid = ((jnp.abs(q_pos[:, :, None] - k_pos[:, None, :]) <= WA_WINDOW)
             & (k_pos[:, None, :] >= 0) & (k_pos[:, None, :] < S))
    s_loc = jnp.where(valid[None, :, None, None], s_loc, -jnp.inf)
    s_ctx = jnp.einsum('bnqkgd,blkd->bnkgql', qb, k_ctx).astype(jnp.float32) * scale
    s_sink = jnp.broadcast_to(sink.astype(jnp.float32).reshape(1, 1, Hkv, G, 1, 1), s_loc.shape[:-1] + (1,))
    p = jax.nn.softmax(jnp.concatenate([s_loc, s_ctx, s_sink], axis=-1), axis=-1).astype(v.dtype)
    o = (jnp.einsum('bnkgqs,bnskd->bnqkgd', p[..., :n_loc], vb)
         + jnp.einsum('bnkgql,blkd->bnqkgd', p[..., n_loc:n_loc + L], v_ctx))
    return o.reshape(B, S, H, Dh)


def gla_chunk_scan(q, k, v, log_a, state0):
    B, T, H, Dk = q.shape
    Dv = v.shape[-1]
    n = T // GLA_CHUNK

    def to_chunks(a):
        return a.astype(jnp.float32).reshape(B, n, GLA_CHUNK, H, a.shape[-1]).transpose(1, 0, 3, 2, 4)

    lower_tri = jnp.tril(jnp.ones((GLA_CHUNK, GLA_CHUNK), dtype=bool))[:, :, None]

    def step(state, inp):
        qc, kc, vc, gc = inp
        b = jnp.cumsum(gc, axis=2)
        b_last = b[:, :, -1:, :]
        o_inter = jnp.einsum('bhck,bhkv->bhcv', qc * jnp.exp(b), state)
        rel = jnp.exp(jnp.where(lower_tri, b[:, :, :, None, :] - b[:, :, None, :, :], -jnp.inf))
        att = jnp.einsum('bhtk,bhsk,bhtsk->bhts', qc, kc, rel)
        o_intra = jnp.einsum('bhts,bhsv->bhtv', att, vc)
        new_state = (jnp.exp(b_last[:, :, 0, :])[..., None] * state
                     + jnp.einsum('bhsk,bhsv->bhkv', kc * jnp.exp(b_last - b), vc))
        return new_state, o_inter + o_intra

    state, o = lax.scan(step, state0, (to_chunks(q), to_chunks(k), to_chunks(v), to_chunks(log_a)))
    o = o.transpose(1, 0, 3, 2, 4).reshape(B, T, H, Dv)
    return o.astype(v.dtype), state


def gla_final_state(k, v, log_a):
    b = jnp.cumsum(log_a.astype(jnp.float32), axis=1)
    w = jnp.exp(b[:, -1:] - b)
    return jnp.einsum('bthk,bthv->bhkv', k.astype(jnp.float32) * w, v.astype(jnp.float32))


def bidirectional_gla(q, k, v, la_f, la_b, q_c, k_c, v_c, la_f_c, la_b_c, need_ctx_out):
    B = k_c.shape[0]
    zero = jnp.zeros((B, GLA_HEADS, GLA_DK, GLA_DV), jnp.float32)
    rev = lambda a: jnp.flip(a, axis=1)
    if need_ctx_out:
        oc_f, s_f = gla_chunk_scan(q_c, k_c, v_c, la_f_c, zero)
        oc_b, s_b = gla_chunk_scan(rev(q_c), rev(k_c), rev(v_c), rev(la_b_c), zero)
        o_ctx = oc_f + rev(oc_b)
    else:
        s_f = gla_final_state(k_c, v_c, la_f_c)
        s_b = gla_final_state(rev(k_c), rev(v_c), rev(la_b_c))
        o_ctx = None
    o_f, _ = gla_chunk_scan(q, k, v, la_f, s_f)
    o_b, _ = gla_chunk_scan(rev(q), rev(k), rev(v), rev(la_b), s_b)
    return o_f + rev(o_b), o_ctx


def merge_groups(o_na, o_wa, o_gla, g_out, gla_norm_g, w_out):
    B, T = o_na.shape[:2]
    o_gla = rms_norm(o_gla, gla_norm_g).reshape(B, T, GLA_V_WIDTH) * jax.nn.silu(g_out)
    y = jnp.concatenate([o_na.reshape(B, T, NA_WIDTH), o_wa.reshape(B, T, WA_Q_WIDTH), o_gla], axis=-1)
    return y @ w_out


def conv_ffn(h, w_up, conv_w, conv_b, w_down):
    value, gate = jnp.split(h @ w_up, 2, axis=-1)
    gate = lax.conv_general_dilated(
        gate, conv_w[:, None, :].astype(gate.dtype), window_strides=(1,),
        padding=((FF_CONV // 2, FF_CONV // 2),), dimension_numbers=('NWC', 'WIO', 'NWC'),
        feature_group_count=FF_DIM) + conv_b
    return (jax.nn.gelu(gate, approximate=False) * value) @ w_down


def setup_inputs(seed: int = 0) -> dict:
    key = jax.random.key(seed)
    ks = jax.random.split(key, 20)

    def nrm(k, shape, scale):
        return jax.random.normal(k, shape, jnp.float32) * scale

    return {
        'x': nrm(ks[0], (BATCH, SEQ, D_MODEL), 1.0),
        'c': nrm(ks[1], (BATCH, D_MODEL), 1.0),
        'ctx': nrm(ks[2], (BATCH, CTX_LEN, D_MODEL), 1.0),
        'c_ctx': nrm(ks[3], (D_MODEL,), 1.0),
        'w_mod': nrm(ks[4], (DEPTH, D_MODEL, 6 * D_MODEL), 0.5 * D_MODEL ** -0.5),
        'b_mod': nrm(ks[5], (DEPTH, 6 * D_MODEL), 0.02),
        'norm1_g': 1.0 + nrm(ks[6], (DEPTH, D_MODEL), 0.05),
        'norm2_g': 1.0 + nrm(ks[7], (DEPTH, D_MODEL), 0.05),
        'w_in': nrm(ks[8], (DEPTH, D_MODEL, IN_WIDTH), D_MODEL ** -0.5),
        'na_rpb': nrm(ks[9], (DEPTH, NA_HEADS, 2 * NA_WIN_R - 1, 2 * NA_WIN_C - 1), 0.1),
        'wa_sink': nrm(ks[10], (DEPTH, WA_HEADS), 0.5),
        'gla_gate_w': nrm(ks[11], (DEPTH, 2, GLA_GATE_RANK, GLA_QK_WIDTH), GLA_GATE_RANK ** -0.5),
        'gla_gate_b': nrm(ks[12], (DEPTH, 2, GLA_QK_WIDTH), 0.1),
        'gla_norm_g': 1.0 + nrm(ks[13], (DEPTH, GLA_DV), 0.05),
        'w_out': nrm(ks[14], (DEPTH, MIX_WIDTH, D_MODEL), MIX_WIDTH ** -0.5),
        'ffn_w_up': nrm(ks[15], (DEPTH, D_MODEL, 2 * FF_DIM), D_MODEL ** -0.5),
        'ffn_conv_w': nrm(ks[16], (DEPTH, FF_CONV, FF_DIM), FF_CONV ** -0.5),
        'ffn_conv_b': nrm(ks[17], (DEPTH, FF_DIM), 0.02),
        'ffn_w_down': nrm(ks[18], (DEPTH, FF_DIM, D_MODEL), FF_DIM ** -0.5),
        'final_norm_g': 1.0 + nrm(ks[19], (D_MODEL,), 0.05),
    }


def reference(x, c, ctx, c_ctx, w_mod, b_mod, norm1_g, norm2_g, w_in, na_rpb, wa_sink,
              gla_gate_w, gla_gate_b, gla_norm_g, w_out, ffn_w_up, ffn_conv_w, ffn_conv_b,
              ffn_w_down, final_norm_g):
    S = x.shape[1]
    cos, sin = axial_rope(S, WA_HEAD_DIM)
    xc = ctx
    silu_c = jax.nn.silu(c)
    silu_cc = jax.nn.silu(c_ctx)
    for i in range(DEPTH):
        last = i == DEPTH - 1
        sh1, sc1, gt1, sh2, sc2, gt2 = jnp.split((silu_c @ w_mod[i] + b_mod[i])[:, None, :], 6, axis=-1)
        csh1, csc1, cgt1, csh2, csc2, cgt2 = jnp.split(silu_cc @ w_mod[i] + b_mod[i], 6, axis=-1)

        lat = mixer_inputs(modulate(x, norm1_g[i], sh1, sc1), w_in[i], gla_gate_w[i], gla_gate_b[i])
        cx = mixer_inputs(modulate(xc, norm1_g[i], csh1, csc1), w_in[i], gla_gate_w[i], gla_gate_b[i])

        o_na = neighbourhood_attention(lat['na_q'], lat['na_k'], lat['na_v'], cx['na_k'], cx['na_v'], na_rpb[i])
        o_wa = window_attention(apply_rope(lat['wa_q'], cos, sin), apply_rope(lat['wa_k'], cos, sin),
                                lat['wa_v'], cx['wa_k'], cx['wa_v'], wa_sink[i])
        o_gla, oc_gla = bidirectional_gla(lat['g_q'], lat['g_k'], lat['g_v'], lat['la_f'], lat['la_b'],
                                          cx['g_q'], cx['g_k'], cx['g_v'], cx['la_f'], cx['la_b'],
                                          not last)
        x = x + gt1 * merge_groups(o_na, o_wa, o_gla, lat['g_out'], gla_norm_g[i], w_out[i])

        x = x + gt2 * conv_ffn(modulate(x, norm2_g[i], sh2, sc2), ffn_w_up[i], ffn_conv_w[i], ffn_conv_b[i], ffn_w_down[i])

        if not last:
            oc_na = context_attention(cx['na_q'], cx['na_k'], cx['na_v'])
            oc_wa = context_attention(cx['wa_q'], cx['wa_k'], cx['wa_v'], wa_sink[i])
            xc = xc + cgt1 * merge_groups(oc_na, oc_wa, oc_gla, cx['g_out'], gla_norm_g[i], w_out[i])
            xc = xc + cgt2 * conv_ffn(modulate(xc, norm2_g[i], csh2, csc2), ffn_w_up[i], ffn_conv_w[i],
                                      ffn_conv_b[i], ffn_w_down[i])
    return rms_norm(x, final_norm_g)
```

```cpp
#include <hip/hip_runtime.h>
#include <cstdio>
#include <cstdint>
namespace pg8 {
#define PG8_LAS __attribute__((address_space(3)))
typedef unsigned short bf16_t;
typedef short bf16x8 __attribute__((ext_vector_type(8)));
typedef float f32x4 __attribute__((ext_vector_type(4)));
typedef unsigned u32x4 __attribute__((ext_vector_type(4)));
constexpr int BM = 256, BK = 64, HALF = 128, HTB = HALF * BK * 2  , STAGE_BYTES = 8 * HTB, NXCD = 8, WGM = 8;

__host__ __device__ __forceinline__ int lds_byte(int r, int c) { const int st = (r >> 4) * 2 + (c >> 5), rr = r & 15, cc = c & 31, ob = rr * 64 + cc * 2; return st * 1024 + (ob ^ (((ob >> 9) & 1) << 5)); }
__host__ __device__ __forceinline__ void stage_rc(int b, int& R, int& C) { const int st = b / 1024, sb = b % 1024, swz = sb ^ (((sb >> 9) & 1) << 5); R = (st >> 1) * 16 + swz / 64; C = (st & 1) * 32 + (swz % 64) / 2; }
__host__ __device__ __forceinline__ int perm32(int rho) { const int n = rho >> 4, i = rho & 15; return 8 * (i >> 2) + 4 * n + (i & 3); }

struct Unit { int pm, pn; };
struct Gemm { const bf16_t* A; const bf16_t* Bt; int M, N, K; };

struct StaticOrder {
    int nM, nN, nwg, G, c;
    __host__ __device__ void init(int M, int N, int G_, int c_) { nM = M / BM; nN = N / BM; nwg = nM * nN; G = G_; c = c_; }
    __host__ __device__ bool next(int i, Unit& u) const {
        const long L = (long)i * G + c; if (L >= nwg) return false;
        int wgid = (int)L; { const int q = nwg / NXCD, r = nwg % NXCD, xcd = wgid % NXCD, off = wgid / NXCD; wgid = (xcd < r ? xcd * (q + 1) : r * (q + 1) + (xcd - r) * q) + off; }
        const int nig = WGM * nN, gid = wgid / nig, fm = gid * WGM, gsz = (nM - fm) < WGM ? (nM - fm) : WGM;
        u.pm = fm + ((wgid % nig) % gsz); u.pn = (wgid % nig) / gsz; return true;
    }
    __device__ __forceinline__ void a_ready(const Unit&) const {}
    __device__ __forceinline__ void done(const Unit&) const {}
};
__device__ __forceinline__ unsigned cvt_pk_bf16(float lo, float hi) { unsigned r; asm volatile("v_cvt_pk_bf16_f32 %0, %1, %2" : "=v"(r) : "v"(lo), "v"(hi)); return r; }
typedef float f32x2 __attribute__((ext_vector_type(2)));
__device__ __forceinline__ f32x2 gelu_pk(f32x2 v) {
    const f32x2 av = __builtin_elementwise_abs(v), d = av * 0.2316418882f + 1.0f;
    f32x2 t; t.x = __builtin_amdgcn_rcpf(d.x); t.y = __builtin_amdgcn_rcpf(d.y);
    f32x2 q = t * 0.5307027145f + (-0.7265760135f); q = q * t + 0.7107068705f; q = q * t + (-0.142248368f); q = q * t + 0.127414796f; q = q * t;
    const f32x2 s = (v * v) * (-0.72134752044f);
    f32x2 e; e.x = __builtin_amdgcn_exp2f(s.x); e.y = __builtin_amdgcn_exp2f(s.y);
    const f32x2 m = v * (q * e), r = v - m;
    f32x2 o; o.x = v.x < 0.f ? m.x : r.x; o.y = v.y < 0.f ? m.y : r.y; return o;
}
typedef unsigned u32x2 __attribute__((ext_vector_type(2)));
constexpr int MLAT = 16384, MCTX = 2048, MTOT = 18432, DMODEL = 1024, NZ = 3328, NUP = 5632, FFD = 2816, MODW = 6144;
__device__ __forceinline__ int seg_of(int grow) { return grow < MLAT ? (grow >> 11) : 8; }
__device__ __forceinline__ float row_rinv(const float* ssq, int grow) {
    const f32x4* sp = (const f32x4*)(ssq + (size_t)grow * 16);
    const f32x4 a = sp[0], b = sp[1], c = sp[2], d = sp[3];
    const float s = ((a[0] + a[1]) + (a[2] + a[3])) + ((b[0] + b[1]) + (b[2] + b[3])) + ((c[0] + c[1]) + (c[2] + c[3])) + ((d[0] + d[1]) + (d[2] + d[3]));
    return 1.0f / sqrtf(s * (1.0f / 1024.0f) + 1e-6f);
}
__device__ __forceinline__ float logsig16(float x) { return (fminf(x, 0.f) - log1pf(expf(-fabsf(x)))) * (1.0f / 16.0f); }

struct EpiIn {
    static constexpr bool PERM = true, AFTER_DRAIN = false;
    bf16_t* Z; const float* ssq; const float* bias; int row_base;
    __device__ __forceinline__ void operator()(const f32x4 (&acc)[2][2][4][2], const Unit& u, int wr, int wc, int fr, int fq) const {
        const int grow0 = row_base + u.pm * BM, seg = seg_of(grow0);
        const int col0 = u.pn * BM + wc * 32 + 8 * fq;
        const float* bs = bias + (size_t)seg * NZ + col0;
        const bool gate = u.pn >= 11;
        f32x4 bv[2][2];
#pragma unroll
        for (int bj = 0; bj < 2; ++bj)
#pragma unroll
            for (int n = 0; n < 2; ++n) bv[bj][n] = *(const f32x4*)(bs + bj * HALF + 4 * n);
#pragma unroll
        for (int ai = 0; ai < 2; ++ai)
#pragma unroll
            for (int m = 0; m < 4; ++m) {
                const int grow = grow0 + ai * HALF + wr * 64 + m * 16 + fr;
                const float ri = row_rinv(ssq, grow);
                bf16_t* rowp = Z + (size_t)grow * NZ + col0;
#pragma unroll
                for (int bj = 0; bj < 2; ++bj) {
                    f32x4 v0 = acc[ai][bj][m][0] * ri + bv[bj][0], v1 = acc[ai][bj][m][1] * ri + bv[bj][1];
                    if (gate) {
#pragma unroll
                        for (int j = 0; j < 4; ++j) { v0[j] = logsig16(v0[j]); v1[j] = logsig16(v1[j]); }
                    }
                    u32x4 w; w.x = cvt_pk_bf16(v0[0], v0[1]); w.y = cvt_pk_bf16(v0[2], v0[3]); w.z = cvt_pk_bf16(v1[0], v1[1]); w.w = cvt_pk_bf16(v1[2], v1[3]);
                    *(u32x4*)(rowp + bj * HALF) = w;
                }
            }
    }
};
struct EpiUp {
    static constexpr bool PERM = true, AFTER_DRAIN = false;
    bf16_t* U; const float* ssq; const float* bias; int row_base;
    __device__ __forceinline__ void operator()(const f32x4 (&acc)[2][2][4][2], const Unit& u, int wr, int wc, int fr, int fq) const {
        const int grow0 = row_base + u.pm * BM, seg = seg_of(grow0);
        const int col0 = u.pn * BM + wc * 32 + 8 * fq;
        const float* bs = bias + (size_t)seg * NUP + col0;
        f32x4 bv[2][2];
#pragma unroll
        for (int bj = 0; bj < 2; ++bj)
#pragma unroll
            for (int n = 0; n < 2; ++n) bv[bj][n] = *(const f32x4*)(bs + bj * HALF + 4 * n);
#pragma unroll
        for (int ai = 0; ai < 2; ++ai)
#pragma unroll
            for (int m = 0; m < 4; ++m) {
                const int lrow = u.pm * BM + ai * HALF + wr * 64 + m * 16 + fr;
                const float ri = row_rinv(ssq, row_base + lrow);
                bf16_t* rowp = U + (size_t)lrow * NUP + col0;
#pragma unroll
                for (int bj = 0; bj < 2; ++bj) {
                    const f32x4 v0 = acc[ai][bj][m][0] * ri + bv[bj][0], v1 = acc[ai][bj][m][1] * ri + bv[bj][1];
                    u32x4 w; w.x = cvt_pk_bf16(v0[0], v0[1]); w.y = cvt_pk_bf16(v0[2], v0[3]); w.z = cvt_pk_bf16(v1[0], v1[1]); w.w = cvt_pk_bf16(v1[2], v1[3]);
                    *(u32x4*)(rowp + bj * HALF) = w;
                }
            }
    }
};
struct EpiRes {
    static constexpr bool PERM = false, AFTER_DRAIN = false;
    const float* xin_lat; const float* xin_ctx; float* xout_lat; float* xout_ctx;
    const float* gt; const float* gn; const float* scn; bf16_t* XM; float* ssq; int row_base;
    __device__ __forceinline__ void operator()(const f32x4 (&acc)[2][2][4][2], const Unit& u, int wr, int wc, int fr, int fq) const {
        const int grow0 = row_base + u.pm * BM, seg = seg_of(grow0);
        const bool lat = grow0 < MLAT;
        const float* xin = lat ? xin_lat + (size_t)grow0 * DMODEL : xin_ctx + (size_t)(grow0 - MLAT) * DMODEL;
        float* xout = lat ? xout_lat + (size_t)grow0 * DMODEL : xout_ctx + (size_t)(grow0 - MLAT) * DMODEL;
        const int col0 = u.pn * BM + wc * 32 + 4 * fq;
        float ss[2][4];
#pragma unroll
        for (int ai = 0; ai < 2; ++ai)
#pragma unroll
            for (int m = 0; m < 4; ++m) ss[ai][m] = 0.f;
#pragma unroll
        for (int bj = 0; bj < 2; ++bj)
#pragma unroll
            for (int n = 0; n < 2; ++n) {
                const int c = col0 + bj * HALF + n * 16;
                const f32x4 gtv = *(const f32x4*)(gt + (size_t)seg * MODW + c);
                f32x4 gmv = (f32x4){0.f, 0.f, 0.f, 0.f};
                if (gn) { const f32x4 g = *(const f32x4*)(gn + c), s = *(const f32x4*)(scn + (size_t)seg * MODW + c); gmv = g * (s + 1.0f); }
#pragma unroll
                for (int ai = 0; ai < 2; ++ai)
#pragma unroll
                    for (int m = 0; m < 4; ++m) {
                        const int lrow = ai * HALF + wr * 64 + m * 16 + fr;
                        const size_t off = (size_t)lrow * DMODEL + c;
                        const f32x4 xo = *(const f32x4*)(xin + off);
                        const f32x4 xn = xo + gtv * acc[ai][bj][m][n];
                        *(f32x4*)(xout + off) = xn;
                        ss[ai][m] += (xn[0] * xn[0] + xn[1] * xn[1]) + (xn[2] * xn[2] + xn[3] * xn[3]);
                        if (gn) { const f32x4 xm = xn * gmv; u32x2 w; w.x = cvt_pk_bf16(xm[0], xm[1]); w.y = cvt_pk_bf16(xm[2], xm[3]);
                            *(u32x2*)(XM + (size_t)(grow0 + lrow) * DMODEL + c) = w; }
                        if (m == 3) asm volatile("" ::: "memory");
                    }
            }
#pragma unroll
        for (int ai = 0; ai < 2; ++ai)
#pragma unroll
            for (int m = 0; m < 4; ++m) {
                const int lrow = ai * HALF + wr * 64 + m * 16 + fr;
                float s = ss[ai][m]; s += __shfl_xor(s, 16); s += __shfl_xor(s, 32);
                if (fq == 0) ssq[(size_t)(grow0 + lrow) * 16 + u.pn * 4 + wc] = s;
            }
    }
};
template <class Epi, class Sched, bool ALIGN_EPI = false, bool SP2 = false>
__device__ __forceinline__ void gemm_phase(PG8_LAS unsigned char* lds, const Gemm g, const Sched& S, const Epi& E) {
    const int tid = threadIdx.x, wid = __builtin_amdgcn_readfirstlane(tid >> 6), lane = tid & 63, wr = wid >> 2, wc = wid & 3, fr = lane & 15, fq = lane >> 4;
    const int K = g.K, nt = K / BK;
    unsigned voffA[2], voffB[2];
#pragma unroll
    for (int i = 0; i < 2; ++i) { int R, C; stage_rc(tid * 16 + i * 8192, R, C); const int Rb = Epi::PERM ? ((R & ~31) + perm32(R & 31)) : R;
        voffA[i] = (unsigned)(R * K + C) * 2u; voffB[i] = (unsigned)(Rb * K + C) * 2u; }
    const size_t kstep = (size_t)(BK * 2);
    const size_t hstep = (size_t)HALF * K * 2;
    const size_t tstep = 2 * hstep;
    const unsigned ldsw = (unsigned)wid * 1024u;
    const int aoff = lds_byte(wr * 64 + fr, fq * 8), boff = lds_byte(wc * 32 + fr, fq * 8);
#define PG8_SA(b, h) (((b) * 2 + (h)) * HTB)
#define PG8_SB(b, h) ((4 + (b) * 2 + (h)) * HTB)
#define PG8_STAGE(bufoff, gbase, voff) do { _Pragma("unroll") for (int _i = 0; _i < 2; ++_i) \
        __builtin_amdgcn_global_load_lds((const unsigned*)((const char*)(gbase) + (voff)[_i]), (PG8_LAS unsigned*)(lds + (bufoff) + ldsw + _i * 8192), 16, 0, 0); } while (0)
#define PG8_LDA(dst, b, h) do { _Pragma("unroll") for (int m = 0; m < 4; ++m) _Pragma("unroll") for (int k = 0; k < 2; ++k) dst[m][k] = *(const PG8_LAS bf16x8*)(lds + PG8_SA(b, h) + aoff + m * 2048 + k * 1024); } while (0)
#define PG8_LDB(dst, b, h) do { _Pragma("unroll") for (int n = 0; n < 2; ++n) _Pragma("unroll") for (int k = 0; k < 2; ++k) dst[n][k] = *(const PG8_LAS bf16x8*)(lds + PG8_SB(b, h) + boff + n * 2048 + k * 1024); } while (0)
#define PG8_MMA(ai, bj, At, Bt) do { __builtin_amdgcn_s_setprio(1); _Pragma("unroll") for (int m = 0; m < 4; ++m) _Pragma("unroll") for (int n = 0; n < 2; ++n) _Pragma("unroll") for (int k = 0; k < 2; ++k) \
        acc[ai][bj][m][n] = __builtin_amdgcn_mfma_f32_16x16x32_bf16(Bt[n][k], At[m][k], acc[ai][bj][m][n], 0, 0, 0); __builtin_amdgcn_s_setprio(0); } while (0)
#define PG8_WAIT_V(n) asm volatile("s_waitcnt vmcnt(" #n ")" ::: "memory")
#define PG8_WAIT_L(n) asm volatile("s_waitcnt lgkmcnt(" #n ")" ::: "memory")
#define PG8_BAR __builtin_amdgcn_s_barrier()
#define PG8_SCHED __builtin_amdgcn_sched_barrier(0)
    Unit cur, nxt; int ui = 0;
    if (!S.next(0, cur)) return;
    f32x4 acc[2][2][4][2];
#pragma unroll
    for (int a = 0; a < 2; ++a)
#pragma unroll
        for (int b = 0; b < 2; ++b)
#pragma unroll
            for (int m = 0; m < 4; ++m)
#pragma unroll
                for (int n = 0; n < 2; ++n) acc[a][b][m][n] = (f32x4){0.f, 0.f, 0.f, 0.f};
    bf16x8 At[4][2], B0[2][2], B1[2][2];
    const char* cA = (const char*)g.A + (size_t)cur.pm * tstep; const char* cB = (const char*)g.Bt + (size_t)cur.pn * tstep;
    S.a_ready(cur);
    if constexpr (SP2) {
        PG8_STAGE(PG8_SB(0, 0), cB, voffB); PG8_STAGE(PG8_SB(0, 1), cB + hstep, voffB); PG8_STAGE(PG8_SA(0, 0), cA, voffA); PG8_STAGE(PG8_SA(0, 1), cA + hstep, voffA);
        if (wr == 1) PG8_BAR;
        PG8_WAIT_V(2); PG8_BAR;
        PG8_STAGE(PG8_SB(1, 0), cB + kstep, voffB); PG8_STAGE(PG8_SA(1, 0), cA + kstep, voffA); PG8_STAGE(PG8_SB(1, 1), cB + hstep + kstep, voffB);
        PG8_WAIT_V(6); PG8_BAR;
    } else {
        PG8_STAGE(PG8_SB(0, 0), cB, voffB); PG8_STAGE(PG8_SA(0, 0), cA, voffA); PG8_STAGE(PG8_SB(0, 1), cB + hstep, voffB); PG8_STAGE(PG8_SA(0, 1), cA + hstep, voffA);
        if (wr == 1) PG8_BAR;
        PG8_WAIT_V(4); PG8_BAR;
        PG8_STAGE(PG8_SB(1, 0), cB + kstep, voffB); PG8_STAGE(PG8_SA(1, 0), cA + kstep, voffA); PG8_STAGE(PG8_SB(1, 1), cB + hstep + kstep, voffB);
        PG8_WAIT_V(6); PG8_BAR;
    }
    for (;;) {
        const bool has_next = S.next(ui + 1, nxt);
        const char* nA = has_next ? (const char*)g.A + (size_t)nxt.pm * tstep : cA; const char* nB = has_next ? (const char*)g.Bt + (size_t)nxt.pn * tstep : cB;
        for (int t = 0; t < nt; t += 2) {
            const bool last = (t == nt - 2);
            const char* a1 = cA + (size_t)(t + 1) * kstep;
            const char* a2 = last ? nA : cA + (size_t)(t + 2) * kstep; const char* b2 = last ? nB : cB + (size_t)(t + 2) * kstep;
            const char* a3 = a2 + kstep; const char* b3 = b2 + kstep;
            if (last && has_next) S.a_ready(nxt);
            if constexpr (SP2) {
            PG8_LDB(B0, 0, 0); PG8_LDB(B1, 0, 1); PG8_SCHED; PG8_LDA(At, 0, 0); PG8_STAGE(PG8_SA(1, 1), a1 + hstep, voffA);
            PG8_WAIT_V(8); PG8_WAIT_L(0); PG8_BAR; PG8_MMA(0, 0, At, B0); PG8_MMA(0, 1, At, B1); PG8_BAR; PG8_SCHED;
            PG8_LDA(At, 0, 1); PG8_STAGE(PG8_SB(0, 0), b2, voffB); PG8_STAGE(PG8_SB(0, 1), b2 + hstep, voffB); PG8_STAGE(PG8_SA(0, 0), a2, voffA);
            PG8_WAIT_V(8); PG8_WAIT_L(0); PG8_BAR; PG8_MMA(1, 0, At, B0); PG8_MMA(1, 1, At, B1); PG8_BAR; PG8_SCHED;
            PG8_LDB(B0, 1, 0); PG8_LDB(B1, 1, 1); PG8_SCHED; PG8_LDA(At, 1, 0); PG8_STAGE(PG8_SA(0, 1), a2 + hstep, voffA);
            PG8_WAIT_V(8); PG8_WAIT_L(0); PG8_BAR; PG8_MMA(0, 0, At, B0); PG8_MMA(0, 1, At, B1); PG8_BAR; PG8_SCHED;
            PG8_LDA(At, 1, 1); PG8_STAGE(PG8_SB(1, 0), b3, voffB); PG8_STAGE(PG8_SB(1, 1), b3 + hstep, voffB); PG8_STAGE(PG8_SA(1, 0), a3, voffA);
            PG8_WAIT_V(8); PG8_WAIT_L(0); PG8_BAR; PG8_MMA(1, 0, At, B0); PG8_MMA(1, 1, At, B1); PG8_BAR; PG8_SCHED;
            } else {
            PG8_LDB(B0, 0, 0); PG8_SCHED; PG8_LDA(At, 0, 0); PG8_STAGE(PG8_SA(1, 1), a1 + hstep, voffA);
            PG8_WAIT_L(8); PG8_BAR; PG8_WAIT_L(0); PG8_MMA(0, 0, At, B0); PG8_BAR; PG8_SCHED;
            PG8_LDB(B1, 0, 1); PG8_STAGE(PG8_SB(0, 0), b2, voffB);
            PG8_BAR; PG8_WAIT_L(0); PG8_MMA(0, 1, At, B1); PG8_BAR;
            PG8_LDA(At, 0, 1); PG8_STAGE(PG8_SA(0, 0), a2, voffA);
            PG8_BAR; PG8_WAIT_L(0); PG8_MMA(1, 0, At, B0); PG8_BAR; PG8_SCHED;
            PG8_STAGE(PG8_SB(0, 1), b2 + hstep, voffB);
            PG8_WAIT_V(6); PG8_BAR; PG8_MMA(1, 1, At, B1); PG8_BAR;
            PG8_LDB(B0, 1, 0); PG8_SCHED; PG8_LDA(At, 1, 0); PG8_STAGE(PG8_SA(0, 1), a2 + hstep, voffA);
            PG8_WAIT_L(8); PG8_BAR; PG8_WAIT_L(0); PG8_MMA(0, 0, At, B0); PG8_BAR; PG8_SCHED;
            PG8_LDB(B1, 1, 1); PG8_STAGE(PG8_SB(1, 0), b3, voffB);
            PG8_BAR; PG8_WAIT_L(0); PG8_MMA(0, 1, At, B1); PG8_BAR;
            PG8_LDA(At, 1, 1); PG8_STAGE(PG8_SA(1, 0), a3, voffA);
            PG8_BAR; PG8_WAIT_L(0); PG8_MMA(1, 0, At, B0); PG8_BAR; PG8_SCHED;
            PG8_STAGE(PG8_SB(1, 1), b3 + hstep, voffB);
            PG8_WAIT_V(6); PG8_BAR; PG8_MMA(1, 1, At, B1); PG8_BAR;
            }
        }
        if constexpr (ALIGN_EPI) { if (wr == 0) PG8_BAR; }
        if constexpr (!Epi::AFTER_DRAIN) { E(acc, cur, wr, wc, fr, fq); S.done(cur); }
        if (!has_next) break;
#pragma unroll
        for (int a = 0; a < 2; ++a)
#pragma unroll
            for (int b = 0; b < 2; ++b)
#pragma unroll
                for (int m = 0; m < 4; ++m)
#pragma unroll
                    for (int n = 0; n < 2; ++n) acc[a][b][m][n] = (f32x4){0.f, 0.f, 0.f, 0.f};
        cur = nxt; cA = nA; cB = nB; ++ui;
        if constexpr (ALIGN_EPI) { if (wr == 1) PG8_BAR; }
    }
    PG8_WAIT_V(0);
    if constexpr (!ALIGN_EPI) { if (wr == 0) PG8_BAR; }
    PG8_BAR;
    if constexpr (Epi::AFTER_DRAIN) { E.fused(acc, cur, wr, wc, fr, fq, lds, wid, lane); S.done(cur); }
#undef PG8_SA
#undef PG8_SB
#undef PG8_STAGE
#undef PG8_LDA
#undef PG8_LDB
#undef PG8_MMA
#undef PG8_WAIT_V
#undef PG8_WAIT_L
#undef PG8_BAR
#undef PG8_SCHED
}
}
using pg8::MLAT; using pg8::MCTX; using pg8::MTOT; using pg8::DMODEL; using pg8::NZ; using pg8::NUP; using pg8::FFD; using pg8::MODW;
constexpr int NWAVES = 8, NTHREADS = 512, DEPTH = 2, NSEG = 9, NINSRC = 2848;
constexpr int LDS_BYTES = 147456;
constexpr int RING_BYTES = 131072;
constexpr int MISC_OFF = RING_BYTES + 320;
#ifndef MK_ONE_LAUNCH
#define MK_ONE_LAUNCH 0
#endif
constexpr int ZC_NAQ = 0, ZC_NAK = 256, ZC_NAV = 512, ZC_WAQ = 768, ZC_WAK = 1024, ZC_WAV = 1152, ZC_GQ = 1280, ZC_GK = 1536, ZC_GV = 1792, ZC_GO = 2304, ZC_GF = 2816, ZC_GB = 3072;
constexpr size_t MiB = 1u << 20, KiB = 1u << 10;
constexpr size_t WS_CTL = 0, CTL_ZERO_BYTES = 1 * MiB;
constexpr size_t WS_MOD = 1 * MiB;
constexpr size_t WS_BIN = 1536 * KiB;
constexpr size_t WS_BUP = 1792 * KiB;
constexpr size_t WS_SSQ = 2304 * KiB;
constexpr size_t WS_WIN = 4 * MiB;
constexpr size_t WS_WOUT = 17 * MiB;
constexpr size_t WS_WUP = 21 * MiB;
constexpr size_t WS_WDN = 43 * MiB;
constexpr size_t WS_XC = 54 * MiB;
constexpr size_t WS_XM = 62 * MiB;
constexpr size_t WS_Y = 98 * MiB;
constexpr size_t WS_Z = 134 * MiB;
constexpr size_t WS_END = 251 * MiB;
constexpr int CW_BAR = 4096;

#define GAS __attribute__((address_space(1)))
#define LAS __attribute__((address_space(3)))
typedef unsigned short bf16;
typedef unsigned v4u __attribute__((ext_vector_type(4)));
typedef unsigned v2u __attribute__((ext_vector_type(2)));
typedef float f32x4 __attribute__((ext_vector_type(4)));
#define LDS_WAIT() asm volatile("s_waitcnt lgkmcnt(0)" ::: "memory")
__device__ __forceinline__ unsigned f2bf(float f) { unsigned u = __builtin_bit_cast(unsigned, f); return (u + 0x7fffu + ((u >> 16) & 1u)) >> 16; }
__device__ __forceinline__ unsigned pk2(float lo, float hi) { return f2bf(lo) | (f2bf(hi) << 16); }
__device__ __forceinline__ float bflo(unsigned w) { return __builtin_bit_cast(float, w << 16); }
__device__ __forceinline__ float bfhi(unsigned w) { return __builtin_bit_cast(float, w & 0xffff0000u); }
__device__ __forceinline__ float bf1(bf16 b) { return __builtin_bit_cast(float, (unsigned)b << 16); }
__device__ __forceinline__ float wave_sum(float v) {
#pragma unroll
    for (int o = 1; o < 64; o <<= 1) v += __shfl_xor(v, o);
    return v;
}
__device__ __forceinline__ float wave_max(float v) {
#pragma unroll
    for (int o = 1; o < 64; o <<= 1) v = fmaxf(v, __shfl_xor(v, o));
    return v;
}
#define XB_TMO      128
#define XB_XCNT(j)  (256  + 64 * (j))
#define XB_XSUB(j)  (1280 + 64 * (j))
#define XB_XGEN(j)  (2304 + 64 * (j))
#define XB_TOP      3328
#define XB_TOPGEN   3392
#define XCD_BAR_WORDS 3456
#define XB_SPIN_CAP (1u << 18)

__device__ __forceinline__ unsigned xb_ld(unsigned* p)              { return __hip_atomic_load(p, __ATOMIC_RELAXED, __HIP_MEMORY_SCOPE_AGENT); }
__device__ __forceinline__ unsigned xb_add(unsigned* p, unsigned v) { return __hip_atomic_fetch_add(p, v, __ATOMIC_RELAXED, __HIP_MEMORY_SCOPE_AGENT); }
__device__ __forceinline__ unsigned xb_xcc_id() { return (unsigned)__builtin_amdgcn_s_getreg((3 << 11) | 20) & 0xFu; }
#define XB_SPIN(cond, bar) do { unsigned _sp = 0; while (cond) { __builtin_amdgcn_s_sleep(1); \
    if ((++_sp & 255u) == 0u) { if (xb_ld(&(bar)[XB_TMO])) break; if (_sp > XB_SPIN_CAP) { atomicAdd(&(bar)[XB_TMO], 1u); break; } } } } while (0)

struct XcdBarrier {
    unsigned* bar; unsigned x;
    volatile LAS unsigned* st;
};

__device__ __forceinline__ XcdBarrier xcd_barrier_post(unsigned* bar, volatile LAS unsigned* st) {
    XcdBarrier b; b.bar = bar; b.x = xb_xcc_id(); b.st = st;
    if (threadIdx.x == 0) (void)xb_add(&bar[XB_XCNT(b.x)], 1u);
    return b;
}
__device__ __forceinline__ void xcd_barrier_complete(unsigned* bar, unsigned x, unsigned& nloc, unsigned& nx) {
    const unsigned G = gridDim.x * gridDim.y * gridDim.z;
    unsigned sum, cnt, mine, sp = 0u;
    for (;;) {
        sum = 0u; cnt = 0u; mine = 0u;
#pragma unroll
        for (unsigned j = 0; j < 16; ++j) { const unsigned c = xb_ld(&bar[XB_XCNT(j)]); sum += c; cnt += (c > 0u) ? 1u : 0u; mine = (j == x) ? c : mine; }
        if (sum == G) break;
        __builtin_amdgcn_s_sleep(1);
        if ((++sp & 255u) == 0u) { if (xb_ld(&bar[XB_TMO])) break; if (sp > XB_SPIN_CAP) { atomicAdd(&bar[XB_TMO], 1u); break; } }
    }
    nloc = mine > 0u ? mine : 1u; nx = cnt > 0u ? cnt : 1u;
}

__device__ __forceinline__ void xcd_barrier(const XcdBarrier& b) {
    asm volatile("s_waitcnt vmcnt(0)" ::: "memory");
    __syncthreads();
    if (threadIdx.x == 0) {
        unsigned* bar = b.bar;
        __builtin_amdgcn_s_waitcnt(0);
        unsigned nloc = b.st[0], nx = b.st[1];
        if (nloc == 0u) { xcd_barrier_complete(bar, b.x, nloc, nx); b.st[0] = nloc; b.st[1] = nx; }
        const unsigned old = xb_add(&bar[XB_XSUB(b.x)], 1u);
        const unsigned gen = old / nloc;
        if (old + 1u == (gen + 1u) * nloc) {
            __builtin_amdgcn_fence(__ATOMIC_RELEASE, "agent");
            asm volatile("s_waitcnt vmcnt(0)" ::: "memory");
            const unsigned og = xb_add(&bar[XB_TOP], 1u);
            const unsigned tg = og / nx;
            if (og + 1u == (tg + 1u) * nx) xb_add(&bar[XB_TOPGEN], 1u);
            else XB_SPIN(xb_ld(&bar[XB_TOPGEN]) == tg, bar);
            __builtin_amdgcn_fence(__ATOMIC_ACQUIRE, "agent");
            xb_add(&bar[XB_XGEN(b.x)], 1u);
            asm volatile("s_waitcnt vmcnt(0)" ::: "memory");
        } else {
            XB_SPIN(xb_ld(&bar[XB_XGEN(b.x)]) == gen, bar);
            __builtin_amdgcn_fence(__ATOMIC_ACQUIRE, "agent");
            asm volatile("s_waitcnt vmcnt(0)" ::: "memory");
        }
    }
    __syncthreads();
}

typedef const float* __attribute__((address_space(4))) const* karg_tab_t;
#define KIN(i) (F.karg[(i)])
#define KOUT() ((float*)(F.karg[20]))
struct Frame {
    LAS unsigned char* lds;
    int tid, lane, wave, vcu, G, bx;
    unsigned char* ws; karg_tab_t karg;
};
enum { I_X = 0, I_C, I_CTX, I_CCTX, I_WMOD, I_BMOD, I_N1G, I_N2G, I_WIN, I_RPB, I_SINK, I_GATEW, I_GATEB, I_GNORM, I_WOUT, I_WUP, I_CONVW, I_CONVB, I_WDN, I_FNG };

__device__ __forceinline__ void gemv64_item(Frame& F, const float* vp, int vstride, const float* vp8, bool do_silu, const float* W, int ldw, int col0, float* out, int ostride, const float* addb) {
    LAS float* tab = (LAS float*)F.lds; LAS float* red = (LAS float*)(F.lds + 36864);
    __syncthreads();
    for (int i = F.tid; i < 9 * 1024; i += NTHREADS) { const int s = i >> 10, k = i & 1023; float v = (s < 8) ? vp[(size_t)s * vstride + k] : vp8[k]; if (do_silu) v = v / (1.0f + expf(-v)); tab[i] = v; }
    __syncthreads();
    float acc[9];
#pragma unroll
    for (int s = 0; s < 9; ++s) acc[s] = 0.f;
    const float* wp = W + (size_t)(F.wave * 128) * ldw + col0 + F.lane;
    const LAS float* tp = tab + F.wave * 128;
#pragma unroll 4
    for (int k = 0; k < 128; ++k) { const float wv = wp[(size_t)k * ldw];
#pragma unroll
        for (int s = 0; s < 9; ++s) acc[s] += tp[s * 1024 + k] * wv; }
#pragma unroll
    for (int s = 0; s < 9; ++s) red[(F.wave * 9 + s) * 64 + F.lane] = acc[s];
    __syncthreads();
    for (int i = F.tid; i < 576; i += NTHREADS) { const int s = i >> 6, n = i & 63; float t = 0.f;
#pragma unroll
        for (int w = 0; w < 8; ++w) t += red[(w * 9 + s) * 64 + n];
        if (addb) t += addb[col0 + n];
        out[(size_t)s * ostride + col0 + n] = t; }
}
__device__ __forceinline__ void transpose_item(const float* W, int ldw, int nblk, bf16* WT, int K, int row_off, LAS float* scr, int item, int lane) {
    const int kb = item / nblk, nb = item % nblk, k0 = 64 * kb, n0 = 32 * nb;
#pragma unroll 8
    for (int i = 0; i < 32; ++i) { const int kk = 2 * i + (lane >> 5); scr[kk * 33 + (lane & 31)] = W[(size_t)(k0 + kk) * ldw + n0 + (lane & 31)]; }
    LDS_WAIT(); asm volatile("" ::: "memory");
    const int c = lane & 7;
#pragma unroll
    for (int j = 0; j < 4; ++j) { const int n = (lane >> 3) + 8 * j; const LAS float* s = scr + (8 * c) * 33 + n;
        v4u o; o.x = pk2(s[0 * 33], s[1 * 33]); o.y = pk2(s[2 * 33], s[3 * 33]); o.z = pk2(s[4 * 33], s[5 * 33]); o.w = pk2(s[6 * 33], s[7 * 33]);
        *(v4u*)(WT + (size_t)(row_off + n0 + n) * K + k0 + 8 * c) = o; }
    LDS_WAIT(); asm volatile("" ::: "memory");
}

__device__ __forceinline__ void phase_p0a(Frame& F) {
    float* mod = (float*)(F.ws + WS_MOD);
    for (int it = F.vcu; it < 2 * 96; it += F.G) {
        const int l = it / 96, cg = it % 96;
        gemv64_item(F, KIN(I_C), 1024, KIN(I_CCTX), true, KIN(I_WMOD) + (size_t)l * 1024 * MODW, MODW, cg * 64, mod + (size_t)l * NSEG * MODW, MODW, KIN(I_BMOD) + (size_t)l * MODW);
    }
    __syncthreads();
    LAS float* scr = (LAS float*)(F.lds + 57344 + F.wave * 8448);
    const int gw = F.vcu * NWAVES + F.wave, NGW = F.G * NWAVES;
    constexpr int I_IN = 16 * 88, I_OUT = 16 * 32, I_UP = 16 * 176, I_DN = 44 * 32, I_L = I_IN + I_OUT + I_UP + I_DN;
    for (int it = gw; it < 2 * I_L; it += NGW) {
        const int l = it / I_L; int r = it % I_L;
        if (r < I_IN) { transpose_item(KIN(I_WIN) + (size_t)l * 1024 * NINSRC, NINSRC, 88, (bf16*)(F.ws + WS_WIN) + (size_t)l * NZ * 1024, 1024, 0, scr, r, F.lane); continue; } r -= I_IN;
        if (r < I_OUT) { transpose_item(KIN(I_WOUT) + (size_t)l * 1024 * 1024, 1024, 32, (bf16*)(F.ws + WS_WOUT) + (size_t)l * 1024 * 1024, 1024, 0, scr, r, F.lane); continue; } r -= I_OUT;
        if (r < I_UP) { transpose_item(KIN(I_WUP) + (size_t)l * 1024 * NUP, NUP, 176, (bf16*)(F.ws + WS_WUP) + (size_t)l * NUP * 1024, 1024, 0, scr, r, F.lane); continue; } r -= I_UP;
        transpose_item(KIN(I_WDN) + (size_t)l * FFD * 1024, 1024, 32, (bf16*)(F.ws + WS_WDN) + (size_t)l * 1024 * FFD, FFD, 0, scr, r, F.lane);
    }
    for (int idx = F.vcu * NTHREADS + F.tid; idx < 2 * 2 * 256 * 128; idx += F.G * NTHREADS) {
        const int n = idx & 255, kg = (idx >> 8) & 127, dir = (idx >> 15) & 1, l = idx >> 16;
        const float* wi = KIN(I_WIN) + (size_t)l * 1024 * NINSRC + (size_t)(kg * 8) * NINSRC + 2816 + 16 * dir;
        const float* gw_ = KIN(I_GATEW) + (size_t)((l * 2 + dir) * 16) * 256 + n;
        float g[16];
#pragma unroll
        for (int j = 0; j < 16; ++j) g[j] = gw_[j * 256];
        float r[8];
#pragma unroll
        for (int kk = 0; kk < 8; ++kk) { const f32x4* wr4 = (const f32x4*)(wi + (size_t)kk * NINSRC); float a = 0.f;
#pragma unroll
            for (int q = 0; q < 4; ++q) { const f32x4 w4 = wr4[q]; a += w4[0] * g[4 * q] + w4[1] * g[4 * q + 1] + w4[2] * g[4 * q + 2] + w4[3] * g[4 * q + 3]; }
            r[kk] = a; }
        v4u o; o.x = pk2(r[0], r[1]); o.y = pk2(r[2], r[3]); o.z = pk2(r[4], r[5]); o.w = pk2(r[6], r[7]);
        *(v4u*)((bf16*)(F.ws + WS_WIN) + (size_t)l * NZ * 1024 + (size_t)(2816 + 256 * dir + n) * 1024 + kg * 8) = o;
    }
}

__device__ __forceinline__ void phase_p0b(Frame& F) {
    const float* mod = (const float*)(F.ws + WS_MOD);
    float* bin = (float*)(F.ws + WS_BIN); float* bup = (float*)(F.ws + WS_BUP);
    constexpr int PER_L = 44 + 88 + 2;
    for (int it = F.vcu; it < 2 * PER_L; it += F.G) {
        const int l = it / PER_L; int r = it % PER_L;
        const float* modl = mod + (size_t)l * NSEG * MODW;
        if (r < 44) { gemv64_item(F, modl + 0, MODW, modl + 8 * MODW + 0, false, KIN(I_WIN) + (size_t)l * 1024 * NINSRC, NINSRC, r * 64, bin + (size_t)l * NSEG * NZ, NZ, nullptr); continue; } r -= 44;
        if (r < 88) { gemv64_item(F, modl + 3072, MODW, modl + 8 * MODW + 3072, false, KIN(I_WUP) + (size_t)l * 1024 * NUP, NUP, r * 64, bup + (size_t)l * NSEG * NUP, NUP, nullptr); continue; } r -= 88;
        {
            const int dir = r;
            LAS float* part = (LAS float*)F.lds;
            LAS float* T = (LAS float*)(F.lds + 4096);
            __syncthreads();
            if (F.tid < 432) { const int pr = F.tid % 144, ks = F.tid / 144, s = pr / 16, j = pr % 16;
                const float* sh = modl + (size_t)s * MODW; const float* wi = KIN(I_WIN) + (size_t)l * 1024 * NINSRC + 2816 + 16 * dir + j;
                const int k0 = ks * 342, k1 = (k0 + 342 < 1024) ? k0 + 342 : 1024; float a = 0.f;
                for (int k = k0; k < k1; ++k) a += sh[k] * wi[(size_t)k * NINSRC];
                part[ks * 144 + pr] = a; }
            __syncthreads();
            if (F.tid < 144) T[F.tid] = part[F.tid] + part[144 + F.tid] + part[288 + F.tid];
            __syncthreads();
            for (int i = F.tid; i < 9 * 256; i += NTHREADS) { const int s = i >> 8, n = i & 255;
                const float* gw_ = KIN(I_GATEW) + (size_t)((l * 2 + dir) * 16) * 256 + n; float a = KIN(I_GATEB)[(l * 2 + dir) * 256 + n];
#pragma unroll
                for (int j = 0; j < 16; ++j) a += T[s * 16 + j] * gw_[j * 256];
                bin[(size_t)l * NSEG * NZ + (size_t)s * NZ + 2816 + 256 * dir + n] = a; }
        }
    }
    const int gw = F.vcu * NWAVES + F.wave, NGW = F.G * NWAVES;
    bf16* XM = (bf16*)(F.ws + WS_XM); float* ssq = (float*)(F.ws + WS_SSQ);
    for (int row = gw; row < MTOT; row += NGW) {
        const float* src = row < MLAT ? KIN(I_X) + (size_t)row * 1024 : KIN(I_CTX) + (size_t)(row - MLAT) * 1024;
        const int seg = pg8::seg_of(row);
        const float* sc1 = mod + (size_t)seg * MODW + 1024; const float* g1 = KIN(I_N1G);
        float ss = 0.f;
#pragma unroll
        for (int j = 0; j < 4; ++j) { const int k = 4 * (F.lane + 64 * j);
            const f32x4 x = *(const f32x4*)(src + k), g = *(const f32x4*)(g1 + k), s = *(const f32x4*)(sc1 + k);
            ss += (x[0] * x[0] + x[1] * x[1]) + (x[2] * x[2] + x[3] * x[3]);
            const f32x4 xm = x * (g * (s + 1.0f)); v2u w; w.x = pk2(xm[0], xm[1]); w.y = pk2(xm[2], xm[3]);
            *(v2u*)(XM + (size_t)row * 1024 + k) = w; }
        ss = wave_sum(ss);
        if (F.lane < 16) ssq[(size_t)row * 16 + F.lane] = (F.lane == 0) ? ss : 0.f;
    }
}

__device__ __forceinline__ void phase_rope(Frame& F) {
    bf16* Z = (bf16*)(F.ws + WS_Z);
    for (int idx = F.vcu * NTHREADS + F.tid; idx < MLAT * 48; idx += F.G * NTHREADS) {
        const int row = idx / 48, r = idx % 48, hh = r >> 3, d0 = (r & 7) * 4;
        const int t = row & 2047;
        bf16* p = Z + (size_t)row * NZ + ZC_WAQ + hh * 64 + d0;
        const v2u a = *(const v2u*)p, b = *(const v2u*)(p + 32);
        float x1[4] = {bflo(a.x), bfhi(a.x), bflo(a.y), bfhi(a.y)}, x2[4] = {bflo(b.x), bfhi(b.x), bflo(b.y), bfhi(b.y)}, o1[4], o2[4];
#pragma unroll
        for (int e = 0; e < 4; ++e) { const int d = d0 + e, f = d & 15; const float pos = (d < 16) ? (float)(t >> 6) : (float)(t & 63);
            const float inv = powf(10000.0f, -(float)f / 16.0f); const float ang = pos * inv; const float cs = cosf(ang), sn = sinf(ang);
            o1[e] = x1[e] * cs - x2[e] * sn; o2[e] = x1[e] * sn + x2[e] * cs; }
        v2u wa, wb; wa.x = pk2(o1[0], o1[1]); wa.y = pk2(o1[2], o1[3]); wb.x = pk2(o2[0], o2[1]); wb.y = pk2(o2[2], o2[3]);
        *(v2u*)p = wa; *(v2u*)(p + 32) = wb;
    }
}

__device__ __forceinline__ float dot64(const bf16* kp, const LAS float* qs) {
    const v4u* k4 = (const v4u*)kp; float d = 0.f;
#pragma unroll
    for (int i = 0; i < 8; ++i) { const v4u w = k4[i]; const LAS float* q = qs + 8 * i;
        d += bflo(w.x) * q[0] + bfhi(w.x) * q[1] + bflo(w.y) * q[2] + bfhi(w.y) * q[3] + bflo(w.z) * q[4] + bfhi(w.z) * q[5] + bflo(w.w) * q[6] + bfhi(w.w) * q[7]; }
    return d;
}
__device__ __forceinline__ void na_item(const bf16* Z, bf16* Y, const float* rpb, int row, int h, LAS float* qs, LAS float* ps, int lane) {
    const bool lat = row < MLAT;
    int b, t = 0; if (lat) { b = row >> 11; t = row & 2047; } else { b = (row - MLAT) >> 8; }
    const int r = t >> 6, c = t & 63;
    const int rs = min(max(r - 4, 0), 24), cs = min(max(c - 8, 0), 48);
    qs[lane] = bf1(Z[(size_t)row * NZ + ZC_NAQ + h * 64 + lane]);
    LDS_WAIT(); asm volatile("" ::: "memory");
    const int nk = lat ? 384 : 256;
    float mx = -INFINITY;
#pragma unroll 1
    for (int kk = 0; kk < 6; ++kk) {
        float s = -INFINITY;
        if (kk * 64 < nk) {
            const int j = kk * 64 + lane; int krow; float bias = 0.f;
            if (lat && j < 128) { const int rr = j >> 4, cc = j & 15; krow = b * 2048 + (rs + rr) * 64 + cs + cc; bias = rpb[(h * 15 + (rs + rr - r + 7)) * 31 + (cs + cc - c + 15)]; }
            else { const int l = lat ? j - 128 : j; krow = MLAT + b * 256 + l; }
            s = dot64(Z + (size_t)krow * NZ + ZC_NAK + h * 64, qs) * 0.125f + bias;
        }
        ps[kk * 64 + lane] = s; mx = fmaxf(mx, s);
    }
    mx = wave_max(mx);
    float sum = 0.f;
#pragma unroll 1
    for (int kk = 0; kk < 6; ++kk) { const float p = (kk * 64 < nk) ? expf(ps[kk * 64 + lane] - mx) : 0.f; ps[kk * 64 + lane] = p; sum += p; }
    sum = wave_sum(sum);
    LDS_WAIT(); asm volatile("" ::: "memory");
    float o = 0.f;
    const bf16* vb = Z + ZC_NAV + h * 64 + lane;
    if (lat) {
#pragma unroll 4
        for (int j = 0; j < 128; ++j) { const int krow = b * 2048 + (rs + (j >> 4)) * 64 + cs + (j & 15); o += ps[j] * bf1(vb[(size_t)krow * NZ]); }
#pragma unroll 4
        for (int l = 0; l < 256; ++l) o += ps[128 + l] * bf1(vb[(size_t)(MLAT + b * 256 + l) * NZ]);
    } else {
#pragma unroll 4
        for (int l = 0; l < 256; ++l) o += ps[l] * bf1(vb[(size_t)(MLAT + b * 256 + l) * NZ]);
    }
    Y[(size_t)row * 1024 + h * 64 + lane] = (bf16)f2bf(o / sum);
    LDS_WAIT(); asm volatile("" ::: "memory");
}
__device__ __forceinline__ void wa_item(const bf16* Z, bf16* Y, const float* sink, int row, int h, LAS float* qs, LAS float* ps, int lane) {
    const bool lat = row < MLAT;
    int b, t = 0; if (lat) { b = row >> 11; t = row & 2047; } else { b = (row - MLAT) >> 8; }
    const int kvh = h >> 1; const float sinkv = sink[h];
    qs[lane] = bf1(Z[(size_t)row * NZ + ZC_WAQ + h * 64 + lane]);
    LDS_WAIT(); asm volatile("" ::: "memory");
    const int rounds = lat ? 9 : 4;
    float mx = sinkv;
#pragma unroll 1
    for (int kk = 0; kk < 9; ++kk) {
        float s = -INFINITY;
        if (kk < rounds) {
            const int j = kk * 64 + lane; int krow = -1;
            if (lat) { if (j < 257) { const int sp = t - 128 + j; if (sp >= 0 && sp < 2048) krow = b * 2048 + sp; } else if (j < 513) krow = MLAT + b * 256 + (j - 257); }
            else krow = MLAT + b * 256 + j;
            if (krow >= 0) s = dot64(Z + (size_t)krow * NZ + ZC_WAK + kvh * 64, qs) * 0.125f;
        }
        ps[kk * 64 + lane] = s; mx = fmaxf(mx, s);
    }
    mx = wave_max(mx);
    float sum = 0.f;
#pragma unroll 1
    for (int kk = 0; kk < 9; ++kk) { const float p = (kk < rounds) ? expf(ps[kk * 64 + lane] - mx) : 0.f; ps[kk * 64 + lane] = p; sum += p; }
    sum = wave_sum(sum) + expf(sinkv - mx);
    LDS_WAIT(); asm volatile("" ::: "memory");
    float o = 0.f;
    const bf16* vb = Z + ZC_WAV + kvh * 64 + lane;
    if (lat) {
        const int s0 = max(t - 128, 0), s1 = min(t + 128, 2047);
#pragma unroll 4
        for (int sp = s0; sp <= s1; ++sp) o += ps[sp - (t - 128)] * bf1(vb[(size_t)(b * 2048 + sp) * NZ]);
#pragma unroll 4
        for (int l = 0; l < 256; ++l) o += ps[257 + l] * bf1(vb[(size_t)(MLAT + b * 256 + l) * NZ]);
    } else {
#pragma unroll 4
        for (int l = 0; l < 256; ++l) o += ps[l] * bf1(vb[(size_t)(MLAT + b * 256 + l) * NZ]);
    }
    Y[(size_t)row * 1024 + 256 + h * 64 + lane] = (bf16)f2bf(o / sum);
    LDS_WAIT(); asm volatile("" ::: "memory");
}
__device__ __forceinline__ void gla_block(Frame& F, const bf16* Z, float* OGF, bf16* Y, const float* gnorm, int b, int h, bool last) {
    LAS float* qL = (LAS float*)F.lds; LAS float* kL = qL + 4096; LAS float* aL = kL + 4096; LAS float* vL = aL + 4096;
    LAS float* osum = vL + 8192; LAS float* red = osum + 8192;
    const int tid = F.tid, dv = tid & 127, kg = tid >> 7;
    for (int pass = 0; pass < 2; ++pass) {
        float S[16];
#pragma unroll
        for (int r = 0; r < 16; ++r) S[r] = 0.f;
        const int gcol = (pass == 0 ? ZC_GF : ZC_GB) + h * 64;
        for (int c = 0; c < 36; ++c) {
            const bool isctx = c < 4;
            const int ci = (pass == 0) ? (isctx ? c : c - 4) : (isctx ? 3 - c : 31 - (c - 4));
            const int base_row = isctx ? MLAT + b * 256 + ci * 64 : b * 2048 + ci * 64;
            __syncthreads();
            {
                const int tok = tid >> 3, d0 = (tid & 7) * 8; const bf16* zr = Z + (size_t)(base_row + tok) * NZ;
                const v4u q4 = *(const v4u*)(zr + ZC_GQ + h * 64 + d0), k4 = *(const v4u*)(zr + ZC_GK + h * 64 + d0), g4 = *(const v4u*)(zr + gcol + d0);
                LAS float* qd = qL + tok * 64 + d0; LAS float* kd = kL + tok * 64 + d0; LAS float* ad = aL + tok * 64 + d0;
                qd[0] = bflo(q4.x) * 0.125f; qd[1] = bfhi(q4.x) * 0.125f; qd[2] = bflo(q4.y) * 0.125f; qd[3] = bfhi(q4.y) * 0.125f; qd[4] = bflo(q4.z) * 0.125f; qd[5] = bfhi(q4.z) * 0.125f; qd[6] = bflo(q4.w) * 0.125f; qd[7] = bfhi(q4.w) * 0.125f;
                kd[0] = bflo(k4.x); kd[1] = bfhi(k4.x); kd[2] = bflo(k4.y); kd[3] = bfhi(k4.y); kd[4] = bflo(k4.z); kd[5] = bfhi(k4.z); kd[6] = bflo(k4.w); kd[7] = bfhi(k4.w);
                ad[0] = expf(bflo(g4.x)); ad[1] = expf(bfhi(g4.x)); ad[2] = expf(bflo(g4.y)); ad[3] = expf(bfhi(g4.y)); ad[4] = expf(bflo(g4.z)); ad[5] = expf(bfhi(g4.z)); ad[6] = expf(bflo(g4.w)); ad[7] = expf(bfhi(g4.w));
#pragma unroll
                for (int i = 0; i < 2; ++i) { const int id2 = tid + 512 * i, tk = id2 >> 4, e0 = (id2 & 15) * 8;
                    const v4u v4 = *(const v4u*)(Z + (size_t)(base_row + tk) * NZ + ZC_GV + h * 128 + e0); LAS float* vd = vL + tk * 128 + e0;
                    vd[0] = bflo(v4.x); vd[1] = bfhi(v4.x); vd[2] = bflo(v4.y); vd[3] = bfhi(v4.y); vd[4] = bflo(v4.z); vd[5] = bfhi(v4.z); vd[6] = bflo(v4.w); vd[7] = bfhi(v4.w); }
                if (pass == 1) {
#pragma unroll 4
                    for (int i = 0; i < 16; ++i) { const int id3 = tid + 512 * i, tk = id3 >> 7, e = id3 & 127; osum[id3] = OGF[(size_t)(base_row + tk) * 512 + h * 128 + e]; }
                }
            }
            __syncthreads();
            for (int i = 0; i < 64; ++i) {
                const int tt = (pass == 0) ? i : 63 - i;
                const float vv = vL[tt * 128 + dv];
                const LAS f32x4* a4 = (const LAS f32x4*)(aL + tt * 64 + 16 * kg); const LAS f32x4* k4 = (const LAS f32x4*)(kL + tt * 64 + 16 * kg); const LAS f32x4* q4 = (const LAS f32x4*)(qL + tt * 64 + 16 * kg);
                float po = 0.f;
#pragma unroll
                for (int g = 0; g < 4; ++g) { const f32x4 av = a4[g], kv = k4[g], qv = q4[g];
#pragma unroll
                    for (int e = 0; e < 4; ++e) { S[4 * g + e] = av[e] * S[4 * g + e] + kv[e] * vv; po += qv[e] * S[4 * g + e]; } }
                red[((i & 1) * 4 + kg) * 128 + dv] = po;
                __syncthreads();
                if (kg == 0) { const LAS float* rp = red + (i & 1) * 512 + dv; const float o = (rp[0] + rp[128]) + (rp[256] + rp[384]);
                    if (pass == 0) OGF[(size_t)(base_row + tt) * 512 + h * 128 + dv] = o; else osum[tt * 128 + dv] += o; }
            }
            if (pass == 1 && !(isctx && last)) {
                __syncthreads();
#pragma unroll 2
                for (int j = 0; j < 8; ++j) { const int tt = F.wave * 8 + j; const float x0 = osum[tt * 128 + F.lane], x1 = osum[tt * 128 + 64 + F.lane];
                    const float ss = wave_sum(x0 * x0 + x1 * x1); const float ri = 1.0f / sqrtf(ss * (1.0f / 128.0f) + 1e-6f);
                    const size_t grow = (size_t)(base_row + tt);
                    const float g0 = bf1(Z[grow * NZ + ZC_GO + h * 128 + F.lane]), g1 = bf1(Z[grow * NZ + ZC_GO + h * 128 + 64 + F.lane]);
                    const float y0 = x0 * ri * gnorm[F.lane] * (g0 / (1.0f + expf(-g0))), y1 = x1 * ri * gnorm[64 + F.lane] * (g1 / (1.0f + expf(-g1)));
                    Y[grow * 1024 + 512 + h * 128 + F.lane] = (bf16)f2bf(y0); Y[grow * 1024 + 512 + h * 128 + 64 + F.lane] = (bf16)f2bf(y1); }
            }
        }
    }
}
__device__ __forceinline__ void phase_mixer(Frame& F, int l, bool last) {
    const bf16* Z = (const bf16*)(F.ws + WS_Z); bf16* Y = (bf16*)(F.ws + WS_Y); float* OGF = (float*)(F.ws + WS_XM);
    if (F.vcu < 32) { gla_block(F, Z, OGF, Y, KIN(I_GNORM) + l * 128, F.vcu >> 2, F.vcu & 3, last); return; }
    LAS float* qs = (LAS float*)(F.lds + F.wave * 4096); LAS float* ps = qs + 64;
    const int gw = (F.vcu - 32) * NWAVES + F.wave, NGW = (F.G - 32) * NWAVES;
    const int nrows = last ? MLAT : MTOT;
    const float* rpb = KIN(I_RPB) + (size_t)l * 4 * 15 * 31; const float* sink = KIN(I_SINK) + l * 4;
    for (int it = gw; it < nrows * 8; it += NGW) {
        const int row = it >> 3, k = it & 7;
        if (k < 4) na_item(Z, Y, rpb, row, k, qs, ps, F.lane); else wa_item(Z, Y, sink, row, k - 4, qs, ps, F.lane);
    }
}

__device__ __forceinline__ void phase_conv(Frame& F, int l, int row_base, int nrows) {
    const bf16* U = (const bf16*)(F.ws + WS_Z); bf16* H = (bf16*)(F.ws + WS_Y);
    const float* cw = KIN(I_CONVW) + (size_t)l * 3 * FFD; const float* cb = KIN(I_CONVB) + (size_t)l * FFD;
    const int total = nrows * 352;
    for (int idx = F.vcu * NTHREADS + F.tid; idx < total; idx += F.G * NTHREADS) {
        const int t = idx / 352, f0 = (idx % 352) * 8; const int grow = row_base + t;
        int pos, len; if (grow < MLAT) { pos = grow & 2047; len = 2048; } else { pos = (grow - MLAT) & 255; len = 256; }
        const bf16* ur = U + (size_t)t * NUP;
        const v4u g1 = *(const v4u*)(ur + FFD + f0), vv = *(const v4u*)(ur + f0);
        v4u g0 = (v4u){0u, 0u, 0u, 0u}, g2 = (v4u){0u, 0u, 0u, 0u};
        if (pos > 0) g0 = *(const v4u*)(ur - NUP + FFD + f0);
        if (pos < len - 1) g2 = *(const v4u*)(ur + NUP + FFD + f0);
        const unsigned a0[4] = {g0.x, g0.y, g0.z, g0.w}, a1[4] = {g1.x, g1.y, g1.z, g1.w}, a2[4] = {g2.x, g2.y, g2.z, g2.w}, av[4] = {vv.x, vv.y, vv.z, vv.w};
        unsigned ow[4];
#pragma unroll
        for (int e = 0; e < 4; ++e) { const int f = f0 + 2 * e;
            const float xl = cw[f] * bflo(a0[e]) + cw[FFD + f] * bflo(a1[e]) + cw[2 * FFD + f] * bflo(a2[e]) + cb[f];
            const float xh = cw[f + 1] * bfhi(a0[e]) + cw[FFD + f + 1] * bfhi(a1[e]) + cw[2 * FFD + f + 1] * bfhi(a2[e]) + cb[f + 1];
            const float gl = 0.5f * xl * (1.0f + erff(xl * 0.70710678118654752f)), gh = 0.5f * xh * (1.0f + erff(xh * 0.70710678118654752f));
            ow[e] = pk2(gl * bflo(av[e]), gh * bfhi(av[e])); }
        *(v4u*)(H + (size_t)t * FFD + f0) = (v4u){ow[0], ow[1], ow[2], ow[3]};
    }
}
__device__ __forceinline__ void phase_final(Frame& F) {
    const int gw = F.vcu * NWAVES + F.wave, NGW = F.G * NWAVES; const float* ssq = (const float*)(F.ws + WS_SSQ); const float* fg = KIN(I_FNG);
    for (int row = gw; row < MLAT; row += NGW) {
        const float ri = pg8::row_rinv(ssq, row); float* p = KOUT() + (size_t)row * 1024;
#pragma unroll
        for (int j = 0; j < 4; ++j) { const int k = 4 * (F.lane + 64 * j); const f32x4 x = *(const f32x4*)(p + k), g = *(const f32x4*)(fg + k); *(f32x4*)(p + k) = x * ri * g; }
    }
}

struct Args { const float* in[20]; float* out; unsigned char* ws; int l, part; };
template <int PT> __device__ __forceinline__ void run_phase(Frame& F, int l, int part) {
    const bool last = (l == DEPTH - 1);
    float* modl = (float*)(F.ws + WS_MOD) + (size_t)l * NSEG * MODW;
    const int prow = part * 6144; const int pn_rows = (part == 2 && last) ? 4096 : 6144;
    if constexpr (PT == 0) phase_p0a(F);
    else if constexpr (PT == 1) phase_p0b(F);
    else if constexpr (PT == 2) {
        pg8::Gemm g{(const pg8::bf16_t*)(F.ws + WS_XM), (const pg8::bf16_t*)(F.ws + WS_WIN) + (size_t)l * NZ * 1024, MTOT, NZ, 1024};
        pg8::StaticOrder S; S.init(MTOT, NZ, F.G, F.bx);
        pg8::EpiIn E{(pg8::bf16_t*)(F.ws + WS_Z), (const float*)(F.ws + WS_SSQ), (const float*)(F.ws + WS_BIN) + (size_t)l * NSEG * NZ, 0};
        pg8::gemm_phase<pg8::EpiIn, pg8::StaticOrder, true, true>(F.lds, g, S, E);
    } else if constexpr (PT == 3) phase_rope(F);
    else if constexpr (PT == 4) phase_mixer(F, l, last);
    else if constexpr (PT == 5) {
        const int M = last ? MLAT : MTOT;
        pg8::Gemm g{(const pg8::bf16_t*)(F.ws + WS_Y), (const pg8::bf16_t*)(F.ws + WS_WOUT) + (size_t)l * 1024 * 1024, M, 1024, 1024};
        pg8::StaticOrder S; S.init(M, 1024, F.G, F.bx);
        pg8::EpiRes E;
        E.xin_lat = (l == 0) ? KIN(I_X) : KOUT(); E.xin_ctx = (l == 0) ? KIN(I_CTX) : (const float*)(F.ws + WS_XC);
        E.xout_lat = KOUT(); E.xout_ctx = (float*)(F.ws + WS_XC);
        E.gt = modl + 2048; E.gn = KIN(I_N2G) + l * 1024; E.scn = modl + 4096;
        E.XM = (pg8::bf16_t*)(F.ws + WS_XM); E.ssq = (float*)(F.ws + WS_SSQ); E.row_base = 0;
        pg8::gemm_phase<pg8::EpiRes, pg8::StaticOrder, true, true>(F.lds, g, S, E);
    } else if constexpr (PT == 6) {
        pg8::Gemm g{(const pg8::bf16_t*)(F.ws + WS_XM) + (size_t)prow * 1024, (const pg8::bf16_t*)(F.ws + WS_WUP) + (size_t)l * NUP * 1024, pn_rows, NUP, 1024};
        pg8::StaticOrder S; S.init(pn_rows, NUP, F.G, F.bx);
        pg8::EpiUp E{(pg8::bf16_t*)(F.ws + WS_Z), (const float*)(F.ws + WS_SSQ), (const float*)(F.ws + WS_BUP) + (size_t)l * NSEG * NUP, prow};
        pg8::gemm_phase<pg8::EpiUp, pg8::StaticOrder, true, true>(F.lds, g, S, E);
    } else if constexpr (PT == 7) phase_conv(F, l, prow, pn_rows);
    else if constexpr (PT == 8) {
        pg8::Gemm g{(const pg8::bf16_t*)(F.ws + WS_Y), (const pg8::bf16_t*)(F.ws + WS_WDN) + (size_t)l * 1024 * FFD, pn_rows, 1024, FFD};
        pg8::StaticOrder S; S.init(pn_rows, 1024, F.G, F.bx);
        pg8::EpiRes E;
        E.xin_lat = KOUT(); E.xin_ctx = (const float*)(F.ws + WS_XC); E.xout_lat = KOUT(); E.xout_ctx = (float*)(F.ws + WS_XC);
        E.gt = modl + 5120;
        if (!last) { E.gn = KIN(I_N1G) + (l + 1) * 1024; E.scn = modl + NSEG * MODW + 1024; } else { E.gn = nullptr; E.scn = nullptr; }
        E.XM = (pg8::bf16_t*)(F.ws + WS_XM); E.ssq = (float*)(F.ws + WS_SSQ); E.row_base = prow;
        pg8::gemm_phase<pg8::EpiRes, pg8::StaticOrder, true, true>(F.lds, g, S, E);
    } else phase_final(F);
}
template <int PT> __global__ void __launch_bounds__(NTHREADS, 2) mk_phase(Args args) {
    extern __shared__ __attribute__((aligned(16))) unsigned char lds_raw[];
    Frame F;
    F.karg = (karg_tab_t)__builtin_amdgcn_kernarg_segment_ptr();
    F.tid = threadIdx.x; F.lane = F.tid & 63; F.wave = __builtin_amdgcn_readfirstlane(F.tid >> 6);
    F.G = gridDim.x; F.bx = blockIdx.x; F.vcu = (F.G % 8 == 0) ? (F.bx % 8) * (F.G / 8) + F.bx / 8 : F.bx;
    F.ws = args.ws; F.lds = (LAS unsigned char*)lds_raw;
    run_phase<PT>(F, args.l, args.part);
}

template <int PT> static void launch_phase(const Args& a, int grid, hipStream_t stream) { hipLaunchKernelGGL(mk_phase<PT>, dim3(grid), dim3(NTHREADS), LDS_BYTES, stream, a); }
extern "C" void kernel_launch(void* const* d_in, const int* in_sizes, int n_in, void* d_out, int out_size, void* d_ws, size_t ws_size, hipStream_t stream) {
    static int grid = 0;
    if (grid == 0) {
        if (n_in != 20 || out_size != MLAT * 1024 || ws_size < WS_END) { fprintf(stderr, "kernel_launch: unexpected shapes (n_in %d out %d ws %zu); nothing launched\n", n_in, out_size, ws_size); grid = -1; return; }
        int dev = 0, cus = 0;
        if (hipGetDevice(&dev) != hipSuccess || hipDeviceGetAttribute(&cus, hipDeviceAttributeMultiprocessorCount, dev) != hipSuccess) { grid = -1; return; }
        const void* fns[10] = {(const void*)mk_phase<0>, (const void*)mk_phase<1>, (const void*)mk_phase<2>, (const void*)mk_phase<3>, (const void*)mk_phase<4>, (const void*)mk_phase<5>, (const void*)mk_phase<6>, (const void*)mk_phase<7>, (const void*)mk_phase<8>, (const void*)mk_phase<9>};
        for (int i = 0; i < 10; ++i) if (hipFuncSetAttribute(fns[i], hipFuncAttributeMaxDynamicSharedMemorySize, LDS_BYTES) != hipSuccess) { fprintf(stderr, "kernel_launch: hipFuncSetAttribute failed\n"); grid = -1; return; }
        (void)hipGetLastError();
        grid = cus;
    }
    if (grid < 0) return;
    Args a{};
    for (int i = 0; i < 20; ++i) a.in[i] = (const float*)d_in[i];
    a.out = (float*)d_out; a.ws = (unsigned char*)d_ws; a.l = 0; a.part = 0;
    launch_phase<0>(a, grid, stream);
    launch_phase<1>(a, grid, stream);
    for (int l = 0; l < DEPTH; ++l) {
        a.l = l; a.part = 0;
        launch_phase<2>(a, grid, stream);
        launch_phase<3>(a, grid, stream);
        launch_phase<4>(a, grid, stream);
        launch_phase<5>(a, grid, stream);
        for (int p = 0; p < 3; ++p) { a.part = p; launch_phase<6>(a, grid, stream); launch_phase<7>(a, grid, stream); launch_phase<8>(a, grid, stream); }
    }
    a.l = 0; a.part = 0;
    launch_phase<9>(a, grid, stream);
}
```

```cpp
#include <hip/hip_runtime.h>
#include <cstdio>
#include <cstdint>
__device__ __forceinline__ float lxor(float v, int lane, int X) { return __builtin_bit_cast(float, __builtin_amdgcn_ds_bpermute((lane ^ X) << 2, __builtin_bit_cast(int, v))); }
__device__ __forceinline__ float xmax_16_32(float v) {
    unsigned a = __builtin_bit_cast(unsigned, v), b = a;
    asm("s_nop 1\n\tv_permlane16_swap_b32 %0, %1\n\ts_nop 1" : "+v"(a), "+v"(b));
    const float m = fmaxf(__builtin_bit_cast(float, a), __builtin_bit_cast(float, b));
    a = __builtin_bit_cast(unsigned, m); b = a;
    asm("s_nop 1\n\tv_permlane32_swap_b32 %0, %1\n\ts_nop 1" : "+v"(a), "+v"(b));
    return fmaxf(__builtin_bit_cast(float, a), __builtin_bit_cast(float, b));
}
__device__ __forceinline__ float xsum_16_32(float v) {
    unsigned a = __builtin_bit_cast(unsigned, v), b = a;
    asm("s_nop 1\n\tv_permlane16_swap_b32 %0, %1\n\ts_nop 1" : "+v"(a), "+v"(b));
    const float m = __builtin_bit_cast(float, a) + __builtin_bit_cast(float, b);
    a = __builtin_bit_cast(unsigned, m); b = a;
    asm("s_nop 1\n\tv_permlane32_swap_b32 %0, %1\n\ts_nop 1" : "+v"(a), "+v"(b));
    return __builtin_bit_cast(float, a) + __builtin_bit_cast(float, b);
}
namespace pg8 {
#define PG8_LAS __attribute__((address_space(3)))
typedef unsigned short bf16_t;
typedef short bf16x8 __attribute__((ext_vector_type(8)));
typedef float f32x4 __attribute__((ext_vector_type(4)));
typedef unsigned u32x4 __attribute__((ext_vector_type(4)));
constexpr int BM = 256, BK = 64, HALF = 128, HTB = HALF * BK * 2  , STAGE_BYTES = 8 * HTB, NXCD = 8, WGM = 8;

__host__ __device__ __forceinline__ int lds_byte(int r, int c) { const int st = (r >> 4) * 2 + (c >> 5), rr = r & 15, cc = c & 31, ob = rr * 64 + cc * 2; return st * 1024 + (ob ^ (((ob >> 9) & 1) << 5)); }
__host__ __device__ __forceinline__ void stage_rc(int b, int& R, int& C) { const int st = b / 1024, sb = b % 1024, swz = sb ^ (((sb >> 9) & 1) << 5); R = (st >> 1) * 16 + swz / 64; C = (st & 1) * 32 + (swz % 64) / 2; }
__host__ __device__ __forceinline__ int perm32(int rho) { const int n = rho >> 4, i = rho & 15; return 8 * (i >> 2) + 4 * n + (i & 3); }

struct Unit { int pm, pn; };
struct Gemm { const bf16_t* A; const bf16_t* Bt; int M, N, K, Mstep, Nstep; };

struct StaticOrder {
    int nM, nN, nwg, G, c;
    __host__ __device__ void init(int M, int N, int G_, int c_) { nM = M / BM; nN = N / BM; nwg = nM * nN; G = G_; c = c_; }
    __host__ __device__ bool next(int i, Unit& u) const {
        const long L = (long)i * G + c; if (L >= nwg) return false;
        int wgid = (int)L; { const int q = nwg / NXCD, r = nwg % NXCD, xcd = wgid % NXCD, off = wgid / NXCD; wgid = (xcd < r ? xcd * (q + 1) : r * (q + 1) + (xcd - r) * q) + off; }
        const int nig = WGM * nN, gid = wgid / nig, fm = gid * WGM, gsz = (nM - fm) < WGM ? (nM - fm) : WGM;
        u.pm = fm + ((wgid % nig) % gsz); u.pn = (wgid % nig) / gsz; return true;
    }
    __device__ __forceinline__ void a_ready(const Unit&) const {}
    __device__ __forceinline__ void done(const Unit&) const {}
};

struct UpOrderH {
    StaticOrder a; int nA, nN, nTot, G, c;
    __host__ __device__ void init(int nMA, int nN_, int nHalfRows, int G_, int c_) { nN = nN_; nA = nMA * nN; nTot = nA + nHalfRows * nN; G = G_; c = c_; a.nM = nMA; a.nN = nN; a.nwg = nA; a.G = G_; a.c = c_; }
    __host__ __device__ bool next(int i, Unit& u) const {
        const int L = i * G + c; if (L >= nTot) return false;
        if (L < nA) return a.next(i, u);
        const int r = L - nA; u.pm = 1000 + r / nN; u.pn = r % nN; return true;
    }
};
__device__ __forceinline__ unsigned cvt_pk_bf16(float lo, float hi) { unsigned r; asm volatile("v_cvt_pk_bf16_f32 %0, %1, %2" : "=v"(r) : "v"(lo), "v"(hi)); return r; }
typedef float f32x2 __attribute__((ext_vector_type(2)));
__device__ __forceinline__ f32x2 gelu_pk(f32x2 v) {
    const f32x2 av = __builtin_elementwise_abs(v), d = av * 0.2316418882f + 1.0f;
    f32x2 t; t.x = __builtin_amdgcn_rcpf(d.x); t.y = __builtin_amdgcn_rcpf(d.y);
    f32x2 q = t * 0.5307027145f + (-0.7265760135f); q = q * t + 0.7107068705f; q = q * t + (-0.142248368f); q = q * t + 0.127414796f; q = q * t;
    const f32x2 s = (v * v) * (-0.72134752044f);
    f32x2 e; e.x = __builtin_amdgcn_exp2f(s.x); e.y = __builtin_amdgcn_exp2f(s.y);
    const f32x2 m = av * (q * e);
    f32x2 r; r.x = fmaxf(v.x, 0.f); r.y = fmaxf(v.y, 0.f); return r - m;
}
typedef unsigned u32x2 __attribute__((ext_vector_type(2)));
constexpr int MLAT = 16384, MCTX = 2048, MTOT = 18432, DMODEL = 1024, NZ = 3328, NUP = 5632, FFD = 2816, MODW = 6144;
__device__ __forceinline__ int seg_of(int grow) { return grow < MLAT ? (grow >> 11) : 8; }
__device__ __forceinline__ float row_rinv(const float* ssq, int grow) { return 1.0f / sqrtf(ssq[grow] * (1.0f / 1024.0f) + 1e-6f); }
__device__ __forceinline__ float logsig16(float x) {
    const float t = __builtin_amdgcn_exp2f(-fabsf(x) * 1.4426950408889634f); return (fminf(x, 0.f) * 1.4426950408889634f - __builtin_amdgcn_logf(1.0f + t)) * (1.0f / 16.0f); }

template <bool HM> struct EpiInT {
    static constexpr bool PERM = true, AFTER_DRAIN = false;
    bf16_t* Z; const float* ssq; const float* bias; const float* cosT; int row_base;
    __device__ __forceinline__ void operator()(const f32x4 (&acc)[2][2][4][2], const Unit& u, int wr, int wc, int fr, int fq) const {
        asm volatile("; epilogue: per-lane indices re-derived here, not hoisted above the K-loop" : "+v"(fr), "+v"(fq));
        const int grow0 = row_base + u.pm * (HM ? HALF : BM), seg = seg_of(grow0);
        const int col0 = u.pn * BM + wc * 32 + 8 * fq;
        const float* bs = bias + (size_t)seg * NZ;
        const bool gate = u.pn >= 11;
        const bool lat = grow0 < MLAT;
        const int a4 = 4 * (4 * (wc & 1) + fq);
        float riv[2][4];
#pragma unroll
        for (int ai = 0; ai < (HM ? 1 : 2); ++ai)
#pragma unroll
            for (int m = 0; m < 4; ++m) riv[ai][m] = ssq[grow0 + ai * HALF + wr * 64 + m * 16 + fr];
#pragma unroll
        for (int ai = 0; ai < (HM ? 1 : 2); ++ai)
#pragma unroll
            for (int m = 0; m < 4; ++m) riv[ai][m] = 1.0f / sqrtf(riv[ai][m] * (1.0f / 1024.0f) + 1e-6f);
#pragma unroll
        for (int bj = 0; bj < 2; ++bj) {
            const bool rot = (u.pn == 3) || (u.pn == 4 && bj == 0);
            const int hb = u.pn * BM + bj * HALF + (wc >> 1) * 64;
            const int cA = rot ? hb + a4 : col0 + bj * HALF, cB = rot ? hb + 32 + a4 : col0 + bj * HALF + 4;
            const f32x4 b0 = *(const f32x4*)(bs + cA), b1 = *(const f32x4*)(bs + cB);
#pragma unroll
            for (int ai = 0; ai < (HM ? 1 : 2); ++ai)
#pragma unroll
                for (int m = 0; m < 4; ++m) {
                    const int grow = grow0 + ai * HALF + wr * 64 + m * 16 + fr;
                    const float ri = riv[ai][m];
                    f32x4 v0 = acc[ai][bj][m][0] * ri + b0, v1 = acc[ai][bj][m][1] * ri + b1;
                    if (gate) {
#pragma unroll
                        for (int j = 0; j < 4; ++j) { v0[j] = logsig16(v0[j]); v1[j] = logsig16(v1[j]); }
                    }
                    if (rot && lat) { const int t = grow & 2047; const f32x4 cs = *(const f32x4*)(cosT + t * 32 + a4), sn = *(const f32x4*)(cosT + 2048 * 32 + t * 32 + a4);
                        const f32x4 o1 = v0 * cs - v1 * sn, o2 = v0 * sn + v1 * cs; v0 = o1; v1 = o2; }
                    u32x2 w0, w1; w0.x = cvt_pk_bf16(v0[0], v0[1]); w0.y = cvt_pk_bf16(v0[2], v0[3]); w1.x = cvt_pk_bf16(v1[0], v1[1]); w1.y = cvt_pk_bf16(v1[2], v1[3]);
                    if (rot) { *(u32x2*)(Z + (size_t)grow * NZ + cA) = w0; *(u32x2*)(Z + (size_t)grow * NZ + cB) = w1; }
                    else *(u32x4*)(Z + (size_t)grow * NZ + cA) = (u32x4){w0.x, w0.y, w1.x, w1.y};
                }
        }
    }
};
using EpiIn = EpiInT<false>;
template <bool HM> struct EpiUpConvT {
    static constexpr bool PERM = true, AFTER_DRAIN = true;
    bf16_t* H; const float* ssq; const float* bias; const float* cw; const float* cb; int mvalid; int rbase;
    __device__ __forceinline__ void fused(f32x4 (&a)[2][2][4][2], const Unit& u, int wr, int wc, int fr, int fq, PG8_LAS unsigned char* lds, int wid, int lane) const {
        PG8_LAS float* rinvL = (PG8_LAS float*)lds; PG8_LAS int* segL = (PG8_LAS int*)(lds + 1024); PG8_LAS unsigned char* gt = lds + 2048;
        constexpr int NR = HM ? 128 : 256;
        const int row0 = HM ? rbase + u.pm * 126 - 1 : u.pm * 254 - 1;
        const int f0 = u.pn * 128 + wc * 32 + 8 * fq;
        { const int t = wid * 64 + lane; if (t < NR) { const int grow = row0 + t; const int gc = grow < 0 ? 0 : (grow > MTOT - 1 ? MTOT - 1 : grow); rinvL[t] = row_rinv(ssq, gc); segL[t] = seg_of(gc); } }
        asm volatile("s_waitcnt vmcnt(0) lgkmcnt(0)" ::: "memory"); __builtin_amdgcn_s_barrier(); asm volatile("" ::: "memory");
        const int segA = segL[0], segB = segL[NR - 1];
        f32x4 bvA[2][2], bvB[2][2];
#pragma unroll
        for (int n = 0; n < 2; ++n) { bvA[0][n] = *(const f32x4*)(bias + (size_t)segA * NUP + f0 + 4 * n); bvA[1][n] = *(const f32x4*)(bias + (size_t)segA * NUP + FFD + f0 + 4 * n);
            bvB[0][n] = *(const f32x4*)(bias + (size_t)segB * NUP + f0 + 4 * n); bvB[1][n] = *(const f32x4*)(bias + (size_t)segB * NUP + FFD + f0 + 4 * n); }
#pragma unroll
        for (int ai = 0; ai < (HM ? 1 : 2); ++ai)
#pragma unroll
            for (int m = 0; m < 4; ++m) {
                const int lrow = ai * HALF + wr * 64 + m * 16 + fr;
                const float ri = rinvL[lrow];
                const bool isA = segL[lrow] == segA;
#pragma unroll
                for (int n = 0; n < 2; ++n) { a[ai][0][m][n] = a[ai][0][m][n] * ri + (isA ? bvA[0][n] : bvB[0][n]); a[ai][1][m][n] = a[ai][1][m][n] * ri + (isA ? bvA[1][n] : bvB[1][n]); }
                u32x4 w; w.x = cvt_pk_bf16(a[ai][1][m][0][0], a[ai][1][m][0][1]); w.y = cvt_pk_bf16(a[ai][1][m][0][2], a[ai][1][m][0][3]); w.z = cvt_pk_bf16(a[ai][1][m][1][0], a[ai][1][m][1][1]); w.w = cvt_pk_bf16(a[ai][1][m][1][2], a[ai][1][m][1][3]);
                *(PG8_LAS u32x4*)(gt + lrow * 272 + (wc * 32 + 8 * fq) * 2) = w;
            }
        asm volatile("s_waitcnt lgkmcnt(0)" ::: "memory"); __builtin_amdgcn_s_barrier(); asm volatile("" ::: "memory");
        unsigned keep[2][4][2];
#pragma unroll
        for (int n = 0; n < 2; ++n) {
            const f32x4 w0 = *(const f32x4*)(cw + f0 + 4 * n), w1 = *(const f32x4*)(cw + FFD + f0 + 4 * n), w2 = *(const f32x4*)(cw + 2 * FFD + f0 + 4 * n), cbv = *(const f32x4*)(cb + f0 + 4 * n);
#pragma unroll
            for (int ai = 0; ai < (HM ? 1 : 2); ++ai)
#pragma unroll
                for (int m = 0; m < 4; ++m) {
                    const int lrow = ai * HALF + wr * 64 + m * 16 + fr, grow = row0 + lrow;
                    int pos, len; if (grow < MLAT) { pos = grow & 2047; len = 2048; } else { pos = (grow - MLAT) & 255; len = 256; }
                    const bool hasup = (lrow > 0) && (pos > 0), hasdn = (lrow < NR - 1) && (pos < len - 1);
                    const int rup = hasup ? lrow - 1 : 475, rdn = hasdn ? lrow + 1 : 475;
                    const u32x2 gu = *(const PG8_LAS u32x2*)(gt + rup * 272 + (wc * 32 + 8 * fq + 4 * n) * 2), gd = *(const PG8_LAS u32x2*)(gt + rdn * 272 + (wc * 32 + 8 * fq + 4 * n) * 2);
                    const unsigned guw[2] = {gu.x, gu.y}, gdw[2] = {gd.x, gd.y};
                    unsigned ow[2];
#pragma unroll
                    for (int q = 0; q < 2; ++q) {
                        const f32x2 u2 = {__builtin_bit_cast(float, guw[q] << 16), __builtin_bit_cast(float, guw[q] & 0xffff0000u)};
                        const f32x2 d2 = {__builtin_bit_cast(float, gdw[q] << 16), __builtin_bit_cast(float, gdw[q] & 0xffff0000u)};
                        const f32x2 own2 = {a[ai][1][m][n][2 * q], a[ai][1][m][n][2 * q + 1]}, val2 = {a[ai][0][m][n][2 * q], a[ai][0][m][n][2 * q + 1]};
                        const f32x2 w0p = {w0[2 * q], w0[2 * q + 1]}, w1p = {w1[2 * q], w1[2 * q + 1]}, w2p = {w2[2 * q], w2[2 * q + 1]}, cbp = {cbv[2 * q], cbv[2 * q + 1]};
                        f32x2 x2 = w0p * u2 + cbp; x2 = w1p * own2 + x2; x2 = w2p * d2 + x2;
                        const f32x2 o2 = gelu_pk(x2) * val2;
                        ow[q] = cvt_pk_bf16(o2.x, o2.y);
                    }
                    if (n == 0) { keep[ai][m][0] = ow[0]; keep[ai][m][1] = ow[1]; }
                    else if (lrow >= 1 && lrow <= NR - 2 && grow < mvalid) *(u32x4*)(H + (size_t)grow * FFD + f0) = (u32x4){keep[ai][m][0], keep[ai][m][1], ow[0], ow[1]};
                    asm volatile("" ::: "memory");
                }
        }
        asm volatile("s_waitcnt lgkmcnt(0)" ::: "memory"); __builtin_amdgcn_s_barrier(); asm volatile("" ::: "memory");
    }
};
using EpiUpConv = EpiUpConvT<false>;
struct OneUnit {
    Unit u;
    __device__ __forceinline__ bool next(int i, Unit& o) const { if (i != 0) return false; o = u; return true; }
    __device__ __forceinline__ void a_ready(const Unit&) const {}
    __device__ __forceinline__ void done(const Unit&) const {}
};
template <bool INF32, bool HM = false, bool HN = false> struct EpiResT {
    static constexpr bool PERM = true, AFTER_DRAIN = false;
    const float* xin_lat; const float* xin_ctx; const bf16_t* xbin; bf16_t* xbout;
    const float* gt; const float* gn; const float* scn; bf16_t* XM; float* ssq; int row_base;
    __device__ __forceinline__ void operator()(const f32x4 (&acc)[2][2][4][2], const Unit& u, int wr, int wc, int fr, int fq) const {
        asm volatile("; epilogue: per-lane indices re-derived here, not hoisted above the K-loop" : "+v"(fr), "+v"(fq));
        const int grow0 = row_base + u.pm * (HM ? HALF : BM), seg = seg_of(grow0);
        const bool lat = grow0 < MLAT;
        const float* xin = INF32 ? (lat ? xin_lat + (size_t)grow0 * DMODEL : xin_ctx + (size_t)(grow0 - MLAT) * DMODEL) : nullptr;
        const bf16_t* xbi = INF32 ? nullptr : xbin + (size_t)grow0 * DMODEL;
        bf16_t* xbo = xbout + (size_t)grow0 * DMODEL;
        const int col0 = u.pn * (HN ? HALF : BM) + wc * 32 + 8 * fq;
        float ss[2][4];
#pragma unroll
        for (int ai = 0; ai < 2; ++ai)
#pragma unroll
            for (int m = 0; m < 4; ++m) ss[ai][m] = 0.f;
        f32x4 xa[2][2], xb[2][2];
        bf16_t* xmb = XM + (size_t)grow0 * DMODEL;
#define ER_LOAD(dst, bj_, ai_, mp_) do { _Pragma("unroll") for (int mm = 0; mm < 2; ++mm) { const unsigned off = (unsigned)(((ai_) * HALF + wr * 64 + (2 * (mp_) + mm) * 16 + fr) * DMODEL + col0 + (bj_) * HALF); \
        if constexpr (INF32) { dst[mm][0] = *(const f32x4*)(xin + off); dst[mm][1] = *(const f32x4*)(xin + off + 4); } \
        else { const u32x4 q_ = *(const u32x4*)(xbi + off); dst[mm][0] = __builtin_bit_cast(f32x4, q_); } } } while (0)
#define ER_DO(src, bj_, ai_, mp_) do { const int c = col0 + (bj_) * HALF; \
        _Pragma("unroll") for (int mm = 0; mm < 2; ++mm) { const int m = 2 * (mp_) + mm; const int lrow = (ai_) * HALF + wr * 64 + m * 16 + fr; const unsigned off = (unsigned)(lrow * DMODEL + c); \
            f32x4 xo0, xo1; \
            if constexpr (INF32) { xo0 = src[mm][0]; xo1 = src[mm][1]; } \
            else { const u32x4 q_ = __builtin_bit_cast(u32x4, src[mm][0]); \
                xo0 = (f32x4){__builtin_bit_cast(float, q_.x << 16), __builtin_bit_cast(float, q_.x & 0xffff0000u), __builtin_bit_cast(float, q_.y << 16), __builtin_bit_cast(float, q_.y & 0xffff0000u)}; \
                xo1 = (f32x4){__builtin_bit_cast(float, q_.z << 16), __builtin_bit_cast(float, q_.z & 0xffff0000u), __builtin_bit_cast(float, q_.w << 16), __builtin_bit_cast(float, q_.w & 0xffff0000u)}; } \
            const f32x4 xn0 = xo0 + gtv[bj_][0] * acc[ai_][bj_][m][0], xn1 = xo1 + gtv[bj_][1] * acc[ai_][bj_][m][1]; \
            { u32x4 w; w.x = cvt_pk_bf16(xn0[0], xn0[1]); w.y = cvt_pk_bf16(xn0[2], xn0[3]); w.z = cvt_pk_bf16(xn1[0], xn1[1]); w.w = cvt_pk_bf16(xn1[2], xn1[3]); *(u32x4*)(xbo + off) = w; } \
            ss[ai_][m] += ((xn0[0] * xn0[0] + xn0[1] * xn0[1]) + (xn0[2] * xn0[2] + xn0[3] * xn0[3])) + ((xn1[0] * xn1[0] + xn1[1] * xn1[1]) + (xn1[2] * xn1[2] + xn1[3] * xn1[3])); \
            if (gn) { const f32x4 xm0 = xn0 * gmv[bj_][0], xm1 = xn1 * gmv[bj_][1]; u32x4 w; w.x = cvt_pk_bf16(xm0[0], xm0[1]); w.y = cvt_pk_bf16(xm0[2], xm0[3]); w.z = cvt_pk_bf16(xm1[0], xm1[1]); w.w = cvt_pk_bf16(xm1[2], xm1[3]); \
                *(u32x4*)(xmb + off) = w; } } } while (0)
        f32x4 gtv[2][2], gmv[2][2];
#define ER_MODV(bj_) do { _Pragma("unroll") for (int n = 0; n < 2; ++n) { const int c = col0 + (bj_) * HALF + 4 * n; gtv[bj_][n] = *(const f32x4*)(gt + (size_t)seg * MODW + c); \
        gmv[bj_][n] = gn ? *(const f32x4*)(gn + c) * (*(const f32x4*)(scn + (size_t)seg * MODW + c) + 1.0f) : (f32x4){0.f, 0.f, 0.f, 0.f}; } } while (0)
        ER_MODV(0);
        ER_LOAD(xa, 0, 0, 0);
#define ER_STEP(cur, nxt, bj_, ai_, mp_, nbj_, nai_, nmp_) do { ER_LOAD(nxt, nbj_, nai_, nmp_); asm volatile("" ::: "memory"); ER_DO(cur, bj_, ai_, mp_); asm volatile("" ::: "memory"); } while (0)
        if constexpr (HM && HN) {
            ER_STEP(xa, xb, 0, 0, 0, 0, 0, 1);
            ER_DO(xb, 0, 0, 1);
        } else if constexpr (HM) {
            ER_STEP(xa, xb, 0, 0, 0, 0, 0, 1);
            ER_MODV(1);
            ER_STEP(xb, xa, 0, 0, 1, 1, 0, 0);
            ER_STEP(xa, xb, 1, 0, 0, 1, 0, 1);
            ER_DO(xb, 1, 0, 1);
        } else {
        ER_STEP(xa, xb, 0, 0, 0, 0, 0, 1);
        ER_STEP(xb, xa, 0, 0, 1, 0, 1, 0);
        ER_STEP(xa, xb, 0, 1, 0, 0, 1, 1);
        ER_MODV(1);
        ER_STEP(xb, xa, 0, 1, 1, 1, 0, 0);
        ER_STEP(xa, xb, 1, 0, 0, 1, 0, 1);
        ER_STEP(xb, xa, 1, 0, 1, 1, 1, 0);
        ER_STEP(xa, xb, 1, 1, 0, 1, 1, 1);
        ER_DO(xb, 1, 1, 1);
        }
#undef ER_STEP
#undef ER_MODV
#undef ER_LOAD
#undef ER_DO
#pragma unroll
        for (int ai = 0; ai < (HM ? 1 : 2); ++ai)
#pragma unroll
            for (int m = 0; m < 4; ++m) {
                const int lrow = ai * HALF + wr * 64 + m * 16 + fr;
                const float s = xsum_16_32(ss[ai][m]);
                if (fq == 0) __hip_atomic_fetch_add(ssq + (grow0 + lrow), s, __ATOMIC_RELAXED, __HIP_MEMORY_SCOPE_AGENT);
            }
    }
};
template <class Epi, class Sched, bool ALIGN_EPI = false, bool SP2 = false, bool HALFM = false, bool HALFN = false>
__device__ __forceinline__ void gemm_phase(PG8_LAS unsigned char* lds, const Gemm g, const Sched& S, const Epi& E, const int tid) {
    const int wid = __builtin_amdgcn_readfirstlane(tid >> 6), lane = tid & 63, wr = wid >> 2, wc = wid & 3, fr = lane & 15, fq = lane >> 4;
    const int K = g.K, nt = K / BK;
    unsigned voffA[2], voffB[2];
#pragma unroll
    for (int i = 0; i < 2; ++i) { int R, C; stage_rc(tid * 16 + i * 8192, R, C); const int Rb = Epi::PERM ? ((R & ~31) + perm32(R & 31)) : R;
        voffA[i] = (unsigned)(R * K + C) * 2u; voffB[i] = (unsigned)(Rb * K + C) * 2u; }
    const size_t kstep = (size_t)(BK * 2);
    const size_t hstep = (size_t)HALF * K * 2;
    const size_t tstep = g.Nstep ? (size_t)g.Nstep * K * 2 : 2 * hstep, tstepA = (size_t)g.Mstep * K * 2;
    const unsigned ldsw = (unsigned)wid * 1024u;
    const int aoff = lds_byte(wr * 64 + fr, fq * 8), boff = lds_byte(wc * 32 + fr, fq * 8);
#define PG8_SA(b, h) (((b) * 2 + (h)) * HTB)
#define PG8_SB(b, h) ((4 + (b) * 2 + (h)) * HTB)
#define PG8_STAGE(bufoff, gbase, voff) do { _Pragma("unroll") for (int _i = 0; _i < 2; ++_i) \
        __builtin_amdgcn_global_load_lds((const unsigned*)((const char*)(gbase) + (voff)[_i]), (PG8_LAS unsigned*)(lds + (bufoff) + ldsw + _i * 8192), 16, 0, 0); } while (0)
#define PG8_LDA(dst, b, h) do { _Pragma("unroll") for (int m = 0; m < 4; ++m) _Pragma("unroll") for (int k = 0; k < 2; ++k) dst[m][k] = *(const PG8_LAS bf16x8*)(lds + PG8_SA(b, h) + aoff + m * 2048 + k * 1024); } while (0)
#define PG8_LDB(dst, b, h) do { _Pragma("unroll") for (int n = 0; n < 2; ++n) _Pragma("unroll") for (int k = 0; k < 2; ++k) dst[n][k] = *(const PG8_LAS bf16x8*)(lds + PG8_SB(b, h) + boff + n * 2048 + k * 1024); } while (0)
#define PG8_MMA(ai, bj, At, Bt) do { __builtin_amdgcn_s_setprio(1); _Pragma("unroll") for (int m = 0; m < 4; ++m) _Pragma("unroll") for (int n = 0; n < 2; ++n) _Pragma("unroll") for (int k = 0; k < 2; ++k) \
        acc[ai][bj][m][n] = __builtin_amdgcn_mfma_f32_16x16x32_bf16(Bt[n][k], At[m][k], acc[ai][bj][m][n], 0, 0, 0); __builtin_amdgcn_s_setprio(0); } while (0)
#define PG8_WAIT_V(n) asm volatile("s_waitcnt vmcnt(" #n ")" ::: "memory")
#define PG8_WAIT_L(n) asm volatile("s_waitcnt lgkmcnt(" #n ")" ::: "memory")
#define PG8_BAR __builtin_amdgcn_s_barrier()
#define PG8_SCHED __builtin_amdgcn_sched_barrier(0)
    Unit cur, nxt; int ui = 0;
    if (!S.next(0, cur)) return;
    f32x4 acc[2][2][4][2];
#pragma unroll
    for (int a = 0; a < 2; ++a)
#pragma unroll
        for (int b = 0; b < 2; ++b)
#pragma unroll
            for (int m = 0; m < 4; ++m)
#pragma unroll
                for (int n = 0; n < 2; ++n) acc[a][b][m][n] = (f32x4){0.f, 0.f, 0.f, 0.f};
    bf16x8 At[4][2], B0[2][2], B1[2][2];
    const char* cA = (const char*)g.A + (size_t)cur.pm * tstepA; const char* cB = (const char*)g.Bt + (size_t)cur.pn * tstep;
    S.a_ready(cur);
    if constexpr (SP2) {
        PG8_STAGE(PG8_SB(0, 0), cB, voffB); PG8_STAGE(PG8_SB(0, 1), cB + hstep, voffB); PG8_STAGE(PG8_SA(0, 0), cA, voffA); PG8_STAGE(PG8_SA(0, 1), cA + hstep, voffA);
        if (wr == 1) PG8_BAR;
        PG8_WAIT_V(2); PG8_BAR;
        PG8_STAGE(PG8_SB(1, 0), cB + kstep, voffB); PG8_STAGE(PG8_SA(1, 0), cA + kstep, voffA); PG8_STAGE(PG8_SB(1, 1), cB + hstep + kstep, voffB);
        PG8_WAIT_V(6); PG8_BAR;
    } else {
        PG8_STAGE(PG8_SB(0, 0), cB, voffB); PG8_STAGE(PG8_SA(0, 0), cA, voffA); PG8_STAGE(PG8_SB(0, 1), cB + hstep, voffB); PG8_STAGE(PG8_SA(0, 1), cA + hstep, voffA);
        if (wr == 1) PG8_BAR;
        PG8_WAIT_V(4); PG8_BAR;
        PG8_STAGE(PG8_SB(1, 0), cB + kstep, voffB); PG8_STAGE(PG8_SA(1, 0), cA + kstep, voffA); PG8_STAGE(PG8_SB(1, 1), cB + hstep + kstep, voffB);
        PG8_WAIT_V(6); PG8_BAR;
    }
    for (;;) {
        const bool has_next = S.next(ui + 1, nxt);
        const char* nA = has_next ? (const char*)g.A + (size_t)nxt.pm * tstepA : cA; const char* nB = has_next ? (const char*)g.Bt + (size_t)nxt.pn * tstep : cB;
        for (int t = 0; t < nt; t += 2) {
            const bool last = (t == nt - 2);
            const char* a1 = cA + (size_t)(t + 1) * kstep;
            const char* a2 = last ? nA : cA + (size_t)(t + 2) * kstep; const char* b2 = last ? nB : cB + (size_t)(t + 2) * kstep;
            const char* a3 = a2 + kstep; const char* b3 = b2 + kstep;
            if (last && has_next) S.a_ready(nxt);
            if constexpr (SP2) {
            PG8_LDB(B0, 0, 0); if constexpr (!HALFN) PG8_LDB(B1, 0, 1); PG8_SCHED; PG8_LDA(At, 0, 0); PG8_STAGE(PG8_SA(1, 1), a1 + hstep, voffA);
            PG8_WAIT_V(8); PG8_WAIT_L(0); PG8_BAR; PG8_MMA(0, 0, At, B0); if constexpr (!HALFN) PG8_MMA(0, 1, At, B1); PG8_BAR; PG8_SCHED;
            if constexpr (!HALFM) PG8_LDA(At, 0, 1); PG8_STAGE(PG8_SB(0, 0), b2, voffB); PG8_STAGE(PG8_SB(0, 1), b2 + hstep, voffB); PG8_STAGE(PG8_SA(0, 0), a2, voffA);
            PG8_WAIT_V(8); PG8_WAIT_L(0); PG8_BAR; if constexpr (!HALFM) { PG8_MMA(1, 0, At, B0); PG8_MMA(1, 1, At, B1); } PG8_BAR; PG8_SCHED;
            PG8_LDB(B0, 1, 0); if constexpr (!HALFN) PG8_LDB(B1, 1, 1); PG8_SCHED; PG8_LDA(At, 1, 0); PG8_STAGE(PG8_SA(0, 1), a2 + hstep, voffA);
            PG8_WAIT_V(8); PG8_WAIT_L(0); PG8_BAR; PG8_MMA(0, 0, At, B0); if constexpr (!HALFN) PG8_MMA(0, 1, At, B1); PG8_BAR; PG8_SCHED;
            if constexpr (!HALFM) PG8_LDA(At, 1, 1); PG8_STAGE(PG8_SB(1, 0), b3, voffB); PG8_STAGE(PG8_SB(1, 1), b3 + hstep, voffB); PG8_STAGE(PG8_SA(1, 0), a3, voffA);
            PG8_WAIT_V(8); PG8_WAIT_L(0); PG8_BAR; if constexpr (!HALFM) { PG8_MMA(1, 0, At, B0); PG8_MMA(1, 1, At, B1); } PG8_BAR; PG8_SCHED;
            } else {
            PG8_LDB(B0, 0, 0); PG8_SCHED; PG8_LDA(At, 0, 0); PG8_STAGE(PG8_SA(1, 1), a1 + hstep, voffA);
            PG8_WAIT_L(8); PG8_BAR; PG8_WAIT_L(0); PG8_MMA(0, 0, At, B0); PG8_BAR; PG8_SCHED;
            PG8_LDB(B1, 0, 1); PG8_STAGE(PG8_SB(0, 0), b2, voffB);
            PG8_BAR; PG8_WAIT_L(0); PG8_MMA(0, 1, At, B1); PG8_BAR;
            PG8_LDA(At, 0, 1); PG8_STAGE(PG8_SA(0, 0), a2, voffA);
            PG8_BAR; PG8_WAIT_L(0); PG8_MMA(1, 0, At, B0); PG8_BAR; PG8_SCHED;
            PG8_STAGE(PG8_SB(0, 1), b2 + hstep, voffB);
            PG8_WAIT_V(6); PG8_BAR; PG8_MMA(1, 1, At, B1); PG8_BAR;
            PG8_LDB(B0, 1, 0); PG8_SCHED; PG8_LDA(At, 1, 0); PG8_STAGE(PG8_SA(0, 1), a2 + hstep, voffA);
            PG8_WAIT_L(8); PG8_BAR; PG8_WAIT_L(0); PG8_MMA(0, 0, At, B0); PG8_BAR; PG8_SCHED;
            PG8_LDB(B1, 1, 1); PG8_STAGE(PG8_SB(1, 0), b3, voffB);
            PG8_BAR; PG8_WAIT_L(0); PG8_MMA(0, 1, At, B1); PG8_BAR;
            PG8_LDA(At, 1, 1); PG8_STAGE(PG8_SA(1, 0), a3, voffA);
            PG8_BAR; PG8_WAIT_L(0); PG8_MMA(1, 0, At, B0); PG8_BAR; PG8_SCHED;
            PG8_STAGE(PG8_SB(1, 1), b3 + hstep, voffB);
            PG8_WAIT_V(6); PG8_BAR; PG8_MMA(1, 1, At, B1); PG8_BAR;
            }
        }
        if constexpr (ALIGN_EPI) { if (wr == 0) PG8_BAR; }
        if constexpr (!Epi::AFTER_DRAIN) { E(acc, cur, wr, wc, fr, fq); S.done(cur); }
        if (!has_next) break;
#pragma unroll
        for (int a = 0; a < 2; ++a)
#pragma unroll
            for (int b = 0; b < 2; ++b)
#pragma unroll
                for (int m = 0; m < 4; ++m)
#pragma unroll
                    for (int n = 0; n < 2; ++n) acc[a][b][m][n] = (f32x4){0.f, 0.f, 0.f, 0.f};
        cur = nxt; cA = nA; cB = nB; ++ui;
        if constexpr (ALIGN_EPI) { if (wr == 1) PG8_BAR; }
    }
    PG8_WAIT_V(0);
    if constexpr (!ALIGN_EPI) { if (wr == 0) PG8_BAR; }
    PG8_BAR;
    if constexpr (Epi::AFTER_DRAIN) { E.fused(acc, cur, wr, wc, fr, fq, lds, wid, lane); S.done(cur); }
#undef PG8_SA
#undef PG8_SB
#undef PG8_STAGE
#undef PG8_LDA
#undef PG8_LDB
#undef PG8_MMA
#undef PG8_WAIT_V
#undef PG8_WAIT_L
#undef PG8_BAR
#undef PG8_SCHED
}
}
using pg8::MLAT; using pg8::MCTX; using pg8::MTOT; using pg8::DMODEL; using pg8::NZ; using pg8::NUP; using pg8::FFD; using pg8::MODW;
constexpr int NWAVES = 8, NTHREADS = 512, DEPTH = 2, NSEG = 9, NINSRC = 2848;
constexpr int LDS_BYTES = 147456;
constexpr int RING_BYTES = 131072;
constexpr int MISC_OFF = LDS_BYTES - 256;
#ifndef MK_ONE_LAUNCH
#define MK_ONE_LAUNCH 0
#endif
constexpr int ZC_NAQ = 0, ZC_NAK = 256, ZC_NAV = 512, ZC_WAQ = 768, ZC_WAK = 1024, ZC_WAV = 1152, ZC_GQ = 1280, ZC_GK = 1536, ZC_GV = 1792, ZC_GO = 2304, ZC_GF = 2816, ZC_GB = 3072;
constexpr size_t MiB = 1u << 20, KiB = 1u << 10;
constexpr size_t WS_CTL = 0, CTL_ZERO_BYTES = 1 * MiB;
constexpr size_t WS_MOD = 1 * MiB;
constexpr size_t WS_BIN = 1536 * KiB;
constexpr size_t WS_BUP = 1792 * KiB;
constexpr size_t WS_SSQA = 64 * KiB, WS_SSQB = 160 * KiB;
constexpr size_t WS_ROPE = 3456 * KiB;
constexpr size_t WS_WIN = 4 * MiB;
constexpr size_t WS_WOUT = 17 * MiB;
constexpr size_t WS_WUP = 21 * MiB;
constexpr size_t WS_WDN = 43 * MiB;
constexpr size_t WS_XC = 54 * MiB;
constexpr size_t WS_XM = 62 * MiB;
constexpr size_t WS_Y = 98 * MiB;
constexpr size_t WS_Z = 134 * MiB;
constexpr size_t WS_END = 251 * MiB;
constexpr int CW_BAR = 4096;
constexpr int CW_UPC = 12288;
constexpr int CW_QUEUE = 8192;

#define GAS __attribute__((address_space(1)))
#define LAS __attribute__((address_space(3)))
typedef unsigned short bf16;
typedef unsigned v4u __attribute__((ext_vector_type(4)));
typedef unsigned v2u __attribute__((ext_vector_type(2)));
typedef float f32x4 __attribute__((ext_vector_type(4)));
#define LDS_WAIT() asm volatile("s_waitcnt lgkmcnt(0)" ::: "memory")
__device__ __forceinline__ unsigned f2bf(float f) { unsigned u = __builtin_bit_cast(unsigned, f); return (u + 0x7fffu + ((u >> 16) & 1u)) >> 16; }
__device__ __forceinline__ unsigned pk2(float lo, float hi) { return f2bf(lo) | (f2bf(hi) << 16); }
__device__ __forceinline__ float bflo(unsigned w) { return __builtin_bit_cast(float, w << 16); }
__device__ __forceinline__ float bfhi(unsigned w) { return __builtin_bit_cast(float, w & 0xffff0000u); }
__device__ __forceinline__ float bf1(bf16 b) { return __builtin_bit_cast(float, (unsigned)b << 16); }
__device__ __forceinline__ float dpp_add(float v, int ctrl_sel) {
    const int x = __builtin_bit_cast(int, v); int y;
    if (ctrl_sel == 0) y = __builtin_amdgcn_update_dpp(x, x, 0xB1, 0xF, 0xF, true);
    else if (ctrl_sel == 1) y = __builtin_amdgcn_update_dpp(x, x, 0x4E, 0xF, 0xF, true);
    else if (ctrl_sel == 2) y = __builtin_amdgcn_update_dpp(x, x, 0x141, 0xF, 0xF, true);
    else y = __builtin_amdgcn_update_dpp(x, x, 0x140, 0xF, 0xF, true);
    return v + __builtin_bit_cast(float, y);
}
__device__ __forceinline__ float wave_sum(float v, int lane) {
    (void)lane;
    v = dpp_add(v, 0); v = dpp_add(v, 1); v = dpp_add(v, 2); v = dpp_add(v, 3);
    return xsum_16_32(v);
}
__device__ __forceinline__ float wave_max(float v, int lane) {
#pragma unroll
    for (int o = 1; o < 64; o <<= 1) v = fmaxf(v, lxor(v, lane, o));
    return v;
}
#define XB_TMO      128
#define XB_XCNT(j)  (256  + 64 * (j))
#define XB_XSUB(j)  (1280 + 64 * (j))
#define XB_XGEN(j)  (2304 + 64 * (j))
#define XB_TOP      3328
#define XB_TOPGEN   3392
#define XCD_BAR_WORDS 3456
#define XB_SPIN_CAP (1u << 18)

__device__ __forceinline__ unsigned xb_ld(unsigned* p)              { return __hip_atomic_load(p, __ATOMIC_RELAXED, __HIP_MEMORY_SCOPE_AGENT); }
__device__ __forceinline__ unsigned xb_add(unsigned* p, unsigned v) { return __hip_atomic_fetch_add(p, v, __ATOMIC_RELAXED, __HIP_MEMORY_SCOPE_AGENT); }
__device__ __forceinline__ unsigned xb_xcc_id() { return (unsigned)__builtin_amdgcn_s_getreg((3 << 11) | 20) & 0xFu; }
#define XB_SPIN(cond, bar) do { unsigned _sp = 0; while (cond) { __builtin_amdgcn_s_sleep(1); \
    if ((++_sp & 255u) == 0u) { if (xb_ld(&(bar)[XB_TMO])) break; if (_sp > XB_SPIN_CAP) { atomicAdd(&(bar)[XB_TMO], 1u); break; } } } } while (0)

struct XcdBarrier {
    unsigned* bar; unsigned x;
    volatile LAS unsigned* st;
};

__device__ __forceinline__ XcdBarrier xcd_barrier_post(unsigned* bar, volatile LAS unsigned* st) {
    XcdBarrier b; b.bar = bar; b.x = xb_xcc_id(); b.st = st;
    if (threadIdx.x == 0) (void)xb_add(&bar[XB_XCNT(b.x)], 1u);
    return b;
}
__device__ __forceinline__ void xcd_barrier_complete(unsigned* bar, unsigned x, unsigned& nloc, unsigned& nx) {
    const unsigned G = gridDim.x * gridDim.y * gridDim.z;
    unsigned sum, cnt, mine, sp = 0u;
    for (;;) {
        sum = 0u; cnt = 0u; mine = 0u;
#pragma unroll
        for (unsigned j = 0; j < 16; ++j) { const unsigned c = xb_ld(&bar[XB_XCNT(j)]); sum += c; cnt += (c > 0u) ? 1u : 0u; mine = (j == x) ? c : mine; }
        if (sum == G) break;
        __builtin_amdgcn_s_sleep(1);
        if ((++sp & 255u) == 0u) { if (xb_ld(&bar[XB_TMO])) break; if (sp > XB_SPIN_CAP) { atomicAdd(&bar[XB_TMO], 1u); break; } }
    }
    nloc = mine > 0u ? mine : 1u; nx = cnt > 0u ? cnt : 1u;
}

__device__ __forceinline__ void xcd_barrier(const XcdBarrier& b, int wave_id) {
    int ln_; asm volatile("v_mbcnt_lo_u32_b32 %0, -1, 0\n\tv_mbcnt_hi_u32_b32 %0, -1, %0" : "=v"(ln_));
    const bool leader_thread = (wave_id == 0) && (ln_ == 0);
    asm volatile("s_waitcnt vmcnt(0)" ::: "memory");
    __syncthreads();
    if (leader_thread) {
        unsigned* bar = b.bar; unsigned bx_ = b.x; asm volatile("; barrier roots re-derived at every call (no per-lane address registers live across phases)" : "+s"(bar), "+s"(bx_));
        __builtin_amdgcn_s_waitcnt(0);
        unsigned nloc = b.st[0], nx = b.st[1];
        if (nloc == 0u) { xcd_barrier_complete(bar, bx_, nloc, nx); b.st[0] = nloc; b.st[1] = nx; }
        const unsigned old = xb_add(&bar[XB_XSUB(bx_)], 1u);
        const unsigned gen = old / nloc;
        if (old + 1u == (gen + 1u) * nloc) {
            __builtin_amdgcn_fence(__ATOMIC_RELEASE, "agent");
            asm volatile("buffer_inv sc1" ::: "memory");
            asm volatile("s_waitcnt vmcnt(0)" ::: "memory");
            const unsigned og = xb_add(&bar[XB_TOP], 1u);
            const unsigned tg = og / nx;
            if (og + 1u == (tg + 1u) * nx) xb_add(&bar[XB_TOPGEN], 1u);
            else XB_SPIN(xb_ld(&bar[XB_TOPGEN]) == tg, bar);
            xb_add(&bar[XB_XGEN(bx_)], 1u);
            __builtin_amdgcn_fence(__ATOMIC_ACQUIRE, "workgroup");
        } else {
            asm volatile("s_waitcnt vmcnt(0)\n\tbuffer_inv sc1" ::: "memory");
            XB_SPIN(xb_ld(&bar[XB_XGEN(bx_)]) == gen, bar);
            asm volatile("s_waitcnt vmcnt(0)" ::: "memory");
            __builtin_amdgcn_fence(__ATOMIC_ACQUIRE, "workgroup");
        }
    }
    __syncthreads();
}

__device__ __forceinline__ void cnt_signal(unsigned* cnt, int tid) {
    asm volatile("s_waitcnt vmcnt(0)" ::: "memory");
    __syncthreads();
    if (tid == 0) {
        __builtin_amdgcn_fence(__ATOMIC_RELEASE, "agent");
        asm volatile("s_waitcnt vmcnt(0)" ::: "memory");
        (void)xb_add(cnt, 1u);
    }
}
__device__ __forceinline__ void cnt_wait(unsigned* cnt, unsigned target, int tid) {
    if (tid == 0) {
        unsigned sp = 0u;
        while (xb_ld(cnt) < target && ++sp < (1u << 24)) __builtin_amdgcn_s_sleep(2);
        __builtin_amdgcn_fence(__ATOMIC_ACQUIRE, "agent");
        asm volatile("s_waitcnt vmcnt(0)" ::: "memory");
    }
    __syncthreads();
}

typedef short bf16x8 __attribute__((ext_vector_type(8)));
typedef short s16x4 __attribute__((ext_vector_type(4)));
typedef short v4i16_t __attribute__((ext_vector_type(4)));
constexpr int VS_STRIDE = 160;
constexpr int VS_BYTES = 64 * VS_STRIDE;
constexpr float LOG2E = 1.4426950408889634f;
__device__ __forceinline__ float ex2(float x) { return __builtin_amdgcn_exp2f(x); }
__device__ __forceinline__ unsigned cvtpk(float lo, float hi) { typedef float f2 __attribute__((ext_vector_type(2))); typedef __bf16 b2 __attribute__((ext_vector_type(2))); f2 v = {lo, hi}; b2 b = __builtin_convertvector(v, b2); return __builtin_bit_cast(unsigned, b); }
__device__ __forceinline__ __amdgpu_buffer_rsrc_t z_rsrc(const bf16* Z) { return __builtin_amdgcn_make_buffer_rsrc((void*)Z, 0, (int)((size_t)MTOT * NZ * 2), 0x00020000); }
__device__ __forceinline__ void load_k(const bf16* Z, const int (&krow)[4], int kcol, int lane, bf16x8 (&kf)[8]) {
    const __amdgpu_buffer_rsrc_t rs = z_rsrc(Z); const int vo = (lane & 15) * (NZ * 2) + (lane >> 4) * 16;
#pragma unroll
    for (int T = 0; T < 4; ++T) { const int so = krow[T] * (NZ * 2) + kcol * 2;
        kf[2 * T] = __builtin_bit_cast(bf16x8, __builtin_amdgcn_raw_buffer_load_b128(rs, vo, so, 0)); kf[2 * T + 1] = __builtin_bit_cast(bf16x8, __builtin_amdgcn_raw_buffer_load_b128(rs, vo, so + 64, 0)); }
}
__device__ __forceinline__ void load_v(const bf16* Z, const int (&krow)[4], int vcol, int lane, v4u (&vr)[8]) {
    const __amdgpu_buffer_rsrc_t rs = z_rsrc(Z); const int vo = (lane >> 3) * (NZ * 2) + (lane & 7) * 16;
#pragma unroll
    for (int T = 0; T < 4; ++T)
#pragma unroll
        for (int i = 0; i < 2; ++i) vr[2 * T + i] = __builtin_amdgcn_raw_buffer_load_b128(rs, vo, (krow[T] + 8 * i) * (NZ * 2) + vcol * 2, 0);
}
__device__ __forceinline__ void stage_v(LAS unsigned char* vs, int lane, const v4u (&vr)[8]) {
#pragma unroll
    for (int T = 0; T < 4; ++T)
#pragma unroll
        for (int i = 0; i < 2; ++i) *(LAS v4u*)(vs + (16 * T + 8 * i + (lane >> 3)) * VS_STRIDE + (lane & 7) * 16) = vr[2 * T + i];
}
template <bool RAW> __device__ __forceinline__ void softmax_pv(LAS unsigned char* vs, int lane, f32x4 (&s)[4], f32x4 (&o)[4], float& m, float& l, float csc) {
    float mx = fmaxf(fmaxf(fmaxf(s[0][0], s[0][1]), fmaxf(s[0][2], s[0][3])), fmaxf(fmaxf(s[1][0], s[1][1]), fmaxf(s[1][2], s[1][3])));
    mx = fmaxf(mx, fmaxf(fmaxf(fmaxf(s[2][0], s[2][1]), fmaxf(s[2][2], s[2][3])), fmaxf(fmaxf(s[3][0], s[3][1]), fmaxf(s[3][2], s[3][3]))));
    mx = xmax_16_32(mx);
    if (RAW) mx *= csc;
    const float mn = fmaxf(m, mx), alpha = ex2(m - mn); m = mn;
    float ls = 0.f;
#pragma unroll
    for (int T = 0; T < 4; ++T)
#pragma unroll
        for (int r = 0; r < 4; ++r) { s[T][r] = RAW ? ex2(__builtin_fmaf(s[T][r], csc, -mn)) : ex2(s[T][r] - mn); ls += s[T][r]; }
    l = l * alpha + ls;
#pragma unroll
    for (int dt = 0; dt < 4; ++dt) o[dt] = o[dt] * alpha;
    v4u pw[2];
#pragma unroll
    for (int ks = 0; ks < 2; ++ks) { pw[ks].x = cvtpk(s[2 * ks][0], s[2 * ks][1]); pw[ks].y = cvtpk(s[2 * ks][2], s[2 * ks][3]); pw[ks].z = cvtpk(s[2 * ks + 1][0], s[2 * ks + 1][1]); pw[ks].w = cvtpk(s[2 * ks + 1][2], s[2 * ks + 1][3]); }
    const int g = lane >> 4, qq = (lane & 15) >> 2, p = lane & 3;
    const LAS unsigned char* vb = vs + (4 * g + qq) * VS_STRIDE + 8 * p;
#pragma unroll
    for (int dt = 0; dt < 4; ++dt)
#pragma unroll
        for (int ks = 0; ks < 2; ++ks) {
            const s16x4 lo = __builtin_bit_cast(s16x4, __builtin_amdgcn_ds_read_tr16_b64_v4i16((LAS v4i16_t*)(vb + (32 * ks) * VS_STRIDE + 32 * dt)));
            const s16x4 hi = __builtin_bit_cast(s16x4, __builtin_amdgcn_ds_read_tr16_b64_v4i16((LAS v4i16_t*)(vb + (32 * ks + 16) * VS_STRIDE + 32 * dt)));
            const bf16x8 va = (bf16x8){lo[0], lo[1], lo[2], lo[3], hi[0], hi[1], hi[2], hi[3]};
            o[dt] = __builtin_amdgcn_mfma_f32_16x16x32_bf16(va, __builtin_bit_cast(bf16x8, pw[ks]), o[dt], 0, 0, 0);
        }
}
__device__ __forceinline__ void qk4(const bf16x8 (&kf)[8], const bf16x8 (&qf)[2], f32x4 (&s)[4]) {
#pragma unroll
    for (int T = 0; T < 4; ++T) { f32x4 z = (f32x4){0.f, 0.f, 0.f, 0.f};
        z = __builtin_amdgcn_mfma_f32_16x16x32_bf16(kf[2 * T], qf[0], z, 0, 0, 0);
        s[T] = __builtin_amdgcn_mfma_f32_16x16x32_bf16(kf[2 * T + 1], qf[1], z, 0, 0, 0); }
}
__device__ __forceinline__ void attn_store(bf16* Y, int row0, int ycol, int lane, const f32x4 (&o)[4], float l) {
    l = xsum_16_32(l);
    const float rl = 1.0f / l; const int q = lane & 15, g = lane >> 4;
#pragma unroll
    for (int dt = 0; dt < 4; ++dt) { v2u w; w.x = cvtpk(o[dt][0] * rl, o[dt][1] * rl); w.y = cvtpk(o[dt][2] * rl, o[dt][3] * rl);
        *(v2u*)(Y + (size_t)(row0 + q) * 1024 + ycol + 16 * dt + 4 * g) = w; }
}
__device__ __forceinline__ void load_q(const bf16* Z, int row0, int qcol, int lane, bf16x8 (&qf)[2]) {
    const bf16* p = Z + (size_t)(row0 + (lane & 15)) * NZ + qcol + 8 * (lane >> 4);
    qf[0] = *(const bf16x8*)p; qf[1] = *(const bf16x8*)(p + 32);
}
__device__ __forceinline__ void na_unit(const bf16* Z, bf16* Y, const LAS float* rpbL, LAS unsigned char* vs, int lane, int unit, int h) {
    const bool lat = unit < MLAT / 16;
    const int row0 = unit * 16;
    int b, r = 0, c0 = 0; if (lat) { b = row0 >> 11; const int t0 = row0 & 2047; r = t0 >> 6; c0 = t0 & 63; } else b = (row0 - MLAT) >> 8;
    const int rs = min(max(r - 4, 0), 24), u0 = min(max(c0 - 8, 0), 32);
    const int q = lane & 15, g = lane >> 4, c = c0 + q, cs = min(max(c - 8, 0), 48);
    const float csc = 0.125f * LOG2E;
    bf16x8 qf[2]; load_q(Z, row0, ZC_NAQ + h * 64, lane, qf);
    int coff[2][4];
#pragma unroll
    for (int hf = 0; hf < 2; ++hf)
#pragma unroll
        for (int rg = 0; rg < 4; ++rg) { const int kc = u0 + 16 * hf + 4 * g + rg; coff[hf][rg] = ((kc >= cs) && (kc < cs + 16)) ? kc - c + 15 : 31; }
    f32x4 o[4]; float m = -1e30f, l = 0.f;
#pragma unroll
    for (int dt = 0; dt < 4; ++dt) o[dt] = (f32x4){0.f, 0.f, 0.f, 0.f};
    const int nch = lat ? 8 : 4, nloc = lat ? 4 : 0;
    int krow[4]; bf16x8 kA[8], kB[8]; v4u vA[8], vB[8];
#define NA_KROW(ch) do { if ((ch) < nloc) { _Pragma("unroll") for (int T = 0; T < 4; ++T) krow[T] = b * 2048 + (rs + 2 * (ch) + (T >> 1)) * 64 + u0 + 16 * (T & 1); } \
                         else { _Pragma("unroll") for (int T = 0; T < 4; ++T) krow[T] = MLAT + b * 256 + 64 * ((ch) - nloc) + 16 * T; } } while (0)
#define NA_STEP(ch_, kX, vX) do { const int ch = (ch_); f32x4 s[4]; qk4(kX, qf, s); \
        if (ch + 2 < nch) { NA_KROW(ch + 2); load_k(Z, krow, ZC_NAK + h * 64, lane, kX); } \
        if (ch < nloc) { _Pragma("unroll") for (int T = 0; T < 4; ++T) { const int wrow = rs + 2 * ch + (T >> 1); const LAS float* bp = rpbL + (h * 15 + (wrow - r + 7)) * 32; \
                _Pragma("unroll") for (int rg = 0; rg < 4; ++rg) s[T][rg] = __builtin_fmaf(s[T][rg], csc, bp[coff[T & 1][rg]]); } } \
        stage_v(vs, lane, vX); \
        if (ch + 2 < nch) load_v(Z, krow, ZC_NAV + h * 64, lane, vX); \
        if (ch < nloc) softmax_pv<false>(vs, lane, s, o, m, l, csc); else softmax_pv<true>(vs, lane, s, o, m, l, csc); } while (0)
    NA_KROW(0); load_k(Z, krow, ZC_NAK + h * 64, lane, kA); load_v(Z, krow, ZC_NAV + h * 64, lane, vA);
    NA_KROW(1); load_k(Z, krow, ZC_NAK + h * 64, lane, kB); load_v(Z, krow, ZC_NAV + h * 64, lane, vB);
    for (int c2 = 0; c2 < nch; c2 += 2) { NA_STEP(c2, kA, vA); NA_STEP(c2 + 1, kB, vB); }
#undef NA_STEP
#undef NA_KROW
    attn_store(Y, row0, h * 64, lane, o, l);
}
__device__ __forceinline__ void wa_unit(const bf16* Z, bf16* Y, const float* sink, LAS unsigned char* vs, int lane, int unit, int kvh) {
    const bool lat = unit < MLAT / 16;
    const int row0 = unit * 16;
    int b, t0 = 0; if (lat) { b = row0 >> 11; t0 = row0 & 2047; } else b = (row0 - MLAT) >> 8;
    const int q = lane & 15, g = lane >> 4, t = t0 + q;
    const float csc = 0.125f * LOG2E;
    bf16x8 qf0[2], qf1[2]; load_q(Z, row0, ZC_WAQ + (2 * kvh) * 64, lane, qf0); load_q(Z, row0, ZC_WAQ + (2 * kvh + 1) * 64, lane, qf1);
    f32x4 o0[4], o1[4];
    float m0 = sink[2 * kvh] * LOG2E, m1 = sink[2 * kvh + 1] * LOG2E, l0 = (g == 0) ? 1.f : 0.f, l1 = l0;
#pragma unroll
    for (int dt = 0; dt < 4; ++dt) { o0[dt] = (f32x4){0.f, 0.f, 0.f, 0.f}; o1[dt] = (f32x4){0.f, 0.f, 0.f, 0.f}; }
    const int nch = lat ? 9 : 4, nloc = lat ? 17 : 0, nreal = lat ? 33 : 16;
    int krow[4]; bf16x8 kf[8]; v4u vr[8];
#define WA_KROW(ch) do { _Pragma("unroll") for (int T = 0; T < 4; ++T) { const int j = 4 * (ch) + T; int kr; \
        if (j < nloc) { const int s0 = t0 - 128 + 16 * j; kr = b * 2048 + min(max(s0, 0), 2032); } else { const int jc = min(j - nloc, 15); kr = MLAT + b * 256 + 16 * jc; } krow[T] = kr; } } while (0)
    WA_KROW(0); load_k(Z, krow, ZC_WAK + kvh * 64, lane, kf); load_v(Z, krow, ZC_WAV + kvh * 64, lane, vr);
    for (int ch = 0; ch < nch; ++ch) {
        f32x4 sa[4], sb[4]; qk4(kf, qf0, sa); qk4(kf, qf1, sb);
        if (ch + 1 < nch) { WA_KROW(ch + 1); load_k(Z, krow, ZC_WAK + kvh * 64, lane, kf); }
#pragma unroll
        for (int T = 0; T < 4; ++T) { const int j = 4 * ch + T;
            bool tv;
            if (j < nloc) { const int s0 = t0 - 128 + 16 * j; tv = (s0 >= 0) && (s0 < 2048); } else tv = j < nreal;
            if (!tv) { sa[T] = (f32x4){-INFINITY, -INFINITY, -INFINITY, -INFINITY}; sb[T] = sa[T]; }
            else if (lat && (j == 0 || j == 16)) {
#pragma unroll
                for (int rg = 0; rg < 4; ++rg) { const bool ok = (j == 0) ? (4 * g + rg >= q) : (4 * g + rg <= q); sa[T][rg] = ok ? sa[T][rg] : -INFINITY; sb[T][rg] = ok ? sb[T][rg] : -INFINITY; }
            }
        }
        stage_v(vs, lane, vr);
        if (ch + 1 < nch) load_v(Z, krow, ZC_WAV + kvh * 64, lane, vr);
        softmax_pv<true>(vs, lane, sa, o0, m0, l0, csc);
        softmax_pv<true>(vs, lane, sb, o1, m1, l1, csc);
    }
#undef WA_KROW
    attn_store(Y, row0, 256 + (2 * kvh) * 64, lane, o0, l0);
    attn_store(Y, row0, 256 + (2 * kvh + 1) * 64, lane, o1, l1);
}

constexpr int AT_NS = 5, AT_STAGE = 16384, AT_RING = AT_NS * AT_STAGE;
__device__ __forceinline__ void at_dma(const bf16* Z, LAS unsigned char* stage, int wave, int lane, int tokrow, int kcol, int vcol) {
    const __amdgpu_buffer_rsrc_t rs = z_rsrc(Z); const int vo = (lane >> 3) * (NZ * 2) + (((lane & 7) ^ (lane >> 3)) << 4);
    __builtin_amdgcn_raw_ptr_buffer_load_lds(rs, (LAS unsigned*)(stage + wave * 1024), 16, vo, tokrow * (NZ * 2) + kcol * 2, 0, 0);
    __builtin_amdgcn_raw_ptr_buffer_load_lds(rs, (LAS unsigned*)(stage + 8192 + wave * 1024), 16, vo, tokrow * (NZ * 2) + vcol * 2, 0, 0);
}
#define AT_WAITV(n) asm volatile("s_waitcnt vmcnt(" #n ")" ::: "memory")
__device__ __forceinline__ void at_kfrag(const LAS unsigned char* const (&sk)[4], const int (&kb)[4], int lane, bf16x8 (&kf)[8]) {
    const int key = lane & 15, g = lane >> 4;
#pragma unroll
    for (int T = 0; T < 4; ++T) { const LAS unsigned char* p = sk[T] + (kb[T] + key) * 128;
        kf[2 * T] = *(const LAS bf16x8*)(p + ((g ^ (key & 7)) << 4)); kf[2 * T + 1] = *(const LAS bf16x8*)(p + (((g + 4) ^ (key & 7)) << 4)); }
}
template <bool RAW> __device__ __forceinline__ void softmax1(int lane, f32x4 (&s)[4], f32x4 (&o)[4], float& m, float& l, float csc, v4u (&pw)[2]) {
    float mx = fmaxf(fmaxf(fmaxf(s[0][0], s[0][1]), fmaxf(s[0][2], s[0][3])), fmaxf(fmaxf(s[1][0], s[1][1]), fmaxf(s[1][2], s[1][3])));
    mx = fmaxf(mx, fmaxf(fmaxf(fmaxf(s[2][0], s[2][1]), fmaxf(s[2][2], s[2][3])), fmaxf(fmaxf(s[3][0], s[3][1]), fmaxf(s[3][2], s[3][3]))));
    mx = xmax_16_32(mx);
    if (RAW) mx *= csc;
    const float mn = fmaxf(m, mx), alpha = ex2(m - mn); m = mn;
    float ls = 0.f;
#pragma unroll
    for (int T = 0; T < 4; ++T)
#pragma unroll
        for (int r = 0; r < 4; ++r) { s[T][r] = RAW ? ex2(__builtin_fmaf(s[T][r], csc, -mn)) : ex2(s[T][r] - mn); ls += s[T][r]; }
    l = l * alpha + ls;
#pragma unroll
    for (int dt = 0; dt < 4; ++dt) o[dt] = o[dt] * alpha;
#pragma unroll
    for (int ks = 0; ks < 2; ++ks) { pw[ks].x = cvtpk(s[2 * ks][0], s[2 * ks][1]); pw[ks].y = cvtpk(s[2 * ks][2], s[2 * ks][3]); pw[ks].z = cvtpk(s[2 * ks + 1][0], s[2 * ks + 1][1]); pw[ks].w = cvtpk(s[2 * ks + 1][2], s[2 * ks + 1][3]); }
}
__device__ __forceinline__ void at_pv(const LAS unsigned char* sv0, const LAS unsigned char* sv1, int v00, int v01, int lane, const v4u (&pw)[2], f32x4 (&o)[4]) {
    const int g = lane >> 4, qq = (lane & 15) >> 2, p = lane & 3, r7 = (4 * g + qq) & 7;
    const LAS unsigned char* vb0 = sv0 + (v00 + 4 * g + qq) * 128 + (p & 1) * 8; const LAS unsigned char* vb1 = sv1 + (v01 + 4 * g + qq) * 128 + (p & 1) * 8;
#pragma unroll
    for (int dt = 0; dt < 4; ++dt) {
        const int sw = (((p >> 1) + 2 * dt) ^ r7) << 4;
#pragma unroll
        for (int ks = 0; ks < 2; ++ks) { const LAS unsigned char* vb = ks ? vb1 : vb0;
            const s16x4 lo = __builtin_bit_cast(s16x4, __builtin_amdgcn_ds_read_tr16_b64_v4i16((LAS v4i16_t*)(vb + sw)));
            const s16x4 hi = __builtin_bit_cast(s16x4, __builtin_amdgcn_ds_read_tr16_b64_v4i16((LAS v4i16_t*)(vb + 16 * 128 + sw)));
            const bf16x8 va = (bf16x8){lo[0], lo[1], lo[2], lo[3], hi[0], hi[1], hi[2], hi[3]};
            o[dt] = __builtin_amdgcn_mfma_f32_16x16x32_bf16(va, __builtin_bit_cast(bf16x8, pw[ks]), o[dt], 0, 0, 0);
        }
    }
}
__device__ __forceinline__ void wa_block(const bf16* Z, bf16* Y, const float* sink, LAS unsigned char* ring, int lane, int wave, int b, int blk, int kvh) {
    const bool lat = blk < 16; const int t0b = 128 * blk, t0 = t0b + 16 * wave;
    const int row0 = lat ? b * 2048 + t0 : MLAT + b * 256 + 128 * (blk - 16) + 16 * wave;
    const int q = lane & 15, g = lane >> 4;
    const float csc = 0.125f * LOG2E;
    bf16x8 qf0[2], qf1[2]; load_q(Z, row0, ZC_WAQ + (2 * kvh) * 64, lane, qf0); load_q(Z, row0, ZC_WAQ + (2 * kvh + 1) * 64, lane, qf1);
    asm volatile("" ::: "memory");
    f32x4 o0[4], o1[4]; int g0_ = g; asm volatile("; per-unit" : "+v"(g0_));
    float m0 = sink[2 * kvh] * LOG2E, m1 = sink[2 * kvh + 1] * LOG2E, l0 = (g0_ == 0) ? 1.f : 0.f, l1 = l0;
#pragma unroll
    for (int dt = 0; dt < 4; ++dt) { o0[dt] = (f32x4){0.f, 0.f, 0.f, 0.f}; o1[dt] = (f32x4){0.f, 0.f, 0.f, 0.f}; }
    const int nloc = lat ? 6 : 0, nch = nloc + 4;
    const int kcol = ZC_WAK + kvh * 64, vcol = ZC_WAV + kvh * 64;
#define WB_TOK(c) ((c) < nloc ? b * 2048 + min(max(t0b - 128 + 64 * (c) + 16 * (wave >> 1), 0), 2032) + 8 * (wave & 1) : MLAT + b * 256 + 64 * ((c) - nloc) + 8 * wave)
    at_dma(Z, ring, wave, lane, WB_TOK(0), kcol, vcol); at_dma(Z, ring + AT_STAGE, wave, lane, WB_TOK(1), kcol, vcol);
    int st = 0, st2 = 2;
    for (int i = 0; i < nch; ++i) {
        if (i + 2 < nch) { at_dma(Z, ring + st2 * AT_STAGE, wave, lane, WB_TOK(i + 2), kcol, vcol); AT_WAITV(4); } else if (i + 1 < nch) AT_WAITV(2); else AT_WAITV(0);
        __builtin_amdgcn_s_barrier(); asm volatile("" ::: "memory");
        bool tv[4]; bool any = false;
#pragma unroll
        for (int T = 0; T < 4; ++T) { const int j = 4 * i + T; if (i < nloc) { const int jr = j - wave, s0 = t0b - 128 + 16 * j; tv[T] = (jr >= 0) && (jr <= 16) && (s0 >= 0) && (s0 < 2048); } else tv[T] = true; any = any || tv[T]; }
        if (any) {
            const LAS unsigned char* sk = ring + st * AT_STAGE;
            const LAS unsigned char* const ska[4] = {sk, sk, sk, sk}; const int kb[4] = {0, 16, 32, 48};
            bf16x8 kf[8]; at_kfrag(ska, kb, lane, kf);
            f32x4 sa[4], sb[4]; v4u pa[2], pb[2]; qk4(kf, qf0, sa); qk4(kf, qf1, sb);
#pragma unroll
            for (int T = 0; T < 4; ++T) { const int jr = 4 * i + T - wave;
                if (!tv[T]) { sa[T] = (f32x4){-INFINITY, -INFINITY, -INFINITY, -INFINITY}; sb[T] = sa[T]; }
                else if (i < nloc && (jr == 0 || jr == 16)) {
#pragma unroll
                    for (int rg = 0; rg < 4; ++rg) { const bool ok = (jr == 0) ? (4 * g + rg >= q) : (4 * g + rg <= q); sa[T][rg] = ok ? sa[T][rg] : -INFINITY; sb[T][rg] = ok ? sb[T][rg] : -INFINITY; }
                }
            }
            softmax1<true>(lane, sa, o0, m0, l0, csc, pa); softmax1<true>(lane, sb, o1, m1, l1, csc, pb);
            at_pv(sk + 8192, sk + 8192, 0, 32, lane, pa, o0); at_pv(sk + 8192, sk + 8192, 0, 32, lane, pb, o1);
            asm volatile("s_waitcnt lgkmcnt(0)" ::: "memory");
        }
        st = (st == AT_NS - 1) ? 0 : st + 1; st2 = (st2 == AT_NS - 1) ? 0 : st2 + 1;
    }
#undef WB_TOK
    attn_store(Y, row0, 256 + (2 * kvh) * 64, lane, o0, l0);
    attn_store(Y, row0, 256 + (2 * kvh + 1) * 64, lane, o1, l1);
    asm volatile("s_waitcnt lgkmcnt(0)" ::: "memory"); __builtin_amdgcn_s_barrier(); asm volatile("" ::: "memory");
}
__device__ __forceinline__ void na_block(const bf16* Z, bf16* Y, const LAS float* rpbL, LAS unsigned char* ring, int lane, int wave, int b, int blk, int h) {
    const bool lat = blk < 16;
    const int r = lat ? 2 * blk + (wave >> 2) : 0, c0 = lat ? 16 * (wave & 3) : 0;
    const int row0 = lat ? b * 2048 + r * 64 + c0 : MLAT + b * 256 + 128 * (blk - 16) + 16 * wave;
    const int rsA = min(max(2 * blk - 4, 0), 24), rsB = min(max(2 * blk + 1 - 4, 0), 24);
    const int rs = min(max(r - 4, 0), 24), u0 = min(max(c0 - 8, 0), 32);
    const int nrow = lat ? rsB - rsA + 8 : 0, nch = nrow + 4, off = rs - rsA;
    const int q = lane & 15, g = lane >> 4, c = c0 + q, cs = min(max(c - 8, 0), 48);
    const float csc = 0.125f * LOG2E;
    bf16x8 qf[2]; load_q(Z, row0, ZC_NAQ + h * 64, lane, qf);
    asm volatile("" ::: "memory");
    int coff[2][4];
#pragma unroll
    for (int hf = 0; hf < 2; ++hf)
#pragma unroll
        for (int rg = 0; rg < 4; ++rg) { const int kc = u0 + 16 * hf + 4 * g + rg; coff[hf][rg] = ((kc >= cs) && (kc < cs + 16)) ? kc - c + 15 : 31; }
    f32x4 o[4]; float m = -1e30f, l = 0.f;
#pragma unroll
    for (int dt = 0; dt < 4; ++dt) o[dt] = (f32x4){0.f, 0.f, 0.f, 0.f};
    const int kcol = ZC_NAK + h * 64, vcol = ZC_NAV + h * 64;
#define NB_TOK(ci) ((ci) < nrow ? b * 2048 + (rsA + (ci)) * 64 + 8 * wave : MLAT + b * 256 + 64 * ((ci) - nrow) + 8 * wave)
    at_dma(Z, ring, wave, lane, NB_TOK(0), kcol, vcol); at_dma(Z, ring + AT_STAGE, wave, lane, NB_TOK(1), kcol, vcol);
    int st = 0, st2 = 2, stp = AT_NS - 1;
    for (int i = 0; i < nch; ++i) {
        if (i + 2 < nch) { at_dma(Z, ring + st2 * AT_STAGE, wave, lane, NB_TOK(i + 2), kcol, vcol); AT_WAITV(4); } else if (i + 1 < nch) AT_WAITV(2); else AT_WAITV(0);
        __builtin_amdgcn_s_barrier(); asm volatile("" ::: "memory");
        const LAS unsigned char* sc = ring + st * AT_STAGE; const LAS unsigned char* sp = ring + stp * AT_STAGE;
        if (i < nrow) {
            const int d = i - 1 - off;
            if (d >= 0 && d <= 6 && (d & 1) == 0) {
                const int k = d >> 1;
                const LAS unsigned char* const ska[4] = {sp, sp, sc, sc}; const int kb[4] = {u0, u0 + 16, u0, u0 + 16};
                bf16x8 kf[8]; at_kfrag(ska, kb, lane, kf);
                f32x4 s[4]; v4u pw[2]; qk4(kf, qf, s);
#pragma unroll
                for (int T = 0; T < 4; ++T) { const int wrow = rs + 2 * k + (T >> 1); const LAS float* bp = rpbL + (h * 15 + (wrow - r + 7)) * 32;
#pragma unroll
                    for (int rg = 0; rg < 4; ++rg) s[T][rg] = __builtin_fmaf(s[T][rg], csc, bp[coff[T & 1][rg]]); }
                softmax1<false>(lane, s, o, m, l, csc, pw);
                at_pv(sp + 8192, sc + 8192, u0, u0, lane, pw, o);
                asm volatile("s_waitcnt lgkmcnt(0)" ::: "memory");
            }
        } else {
            const LAS unsigned char* const ska[4] = {sc, sc, sc, sc}; const int kb[4] = {0, 16, 32, 48};
            bf16x8 kf[8]; at_kfrag(ska, kb, lane, kf);
            f32x4 s[4]; v4u pw[2]; qk4(kf, qf, s);
            softmax1<true>(lane, s, o, m, l, csc, pw);
            at_pv(sc + 8192, sc + 8192, 0, 32, lane, pw, o);
            asm volatile("s_waitcnt lgkmcnt(0)" ::: "memory");
        }
        stp = st; st = (st == AT_NS - 1) ? 0 : st + 1; st2 = (st2 == AT_NS - 1) ? 0 : st2 + 1;
    }
#undef NB_TOK
    attn_store(Y, row0, h * 64, lane, o, l);
    asm volatile("s_waitcnt lgkmcnt(0)" ::: "memory"); __builtin_amdgcn_s_barrier(); asm volatile("" ::: "memory");
}

typedef float f32x16 __attribute__((ext_vector_type(16)));
#define MFMA32(a, b, c) __builtin_amdgcn_mfma_f32_32x32x16_bf16((a), (b), (c), 0, 0, 0)
constexpr int GIM_STRIDE = 192;
constexpr int GL_GIM = 0, GL_QIM = 12288, GL_KRI = 21504, GL_EVP = 30720;
constexpr int GL_SB = 31232, GL_SBSZ = 35328;
constexpr int GL_QF = 0, GL_KF = 8192, GL_KIM = 16384, GL_EV = 28672, GL_XF = 29184;
constexpr int GL_VIM = GL_SB + 2 * GL_SBSZ;
constexpr int GL_FLAG = GL_VIM + 4 * 4096;
constexpr int GL_END = GL_FLAG + 256;
constexpr unsigned GL_SPIN_CAP = 1u << 22;
__device__ __forceinline__ s16x4 trr(const LAS unsigned char* p) { return __builtin_bit_cast(s16x4, __builtin_amdgcn_ds_read_tr16_b64_v4i16((LAS v4i16_t*)p)); }
__device__ __forceinline__ bf16x8 mk8(s16x4 lo, s16x4 hi) { return (bf16x8){lo[0], lo[1], lo[2], lo[3], hi[0], hi[1], hi[2], hi[3]}; }
__device__ __forceinline__ bf16x8 pack8(const f32x16& x, int s) {
    v4u w; w.x = cvtpk(x[8 * s], x[8 * s + 1]); w.y = cvtpk(x[8 * s + 2], x[8 * s + 3]); w.z = cvtpk(x[8 * s + 4], x[8 * s + 5]); w.w = cvtpk(x[8 * s + 6], x[8 * s + 7]);
    return __builtin_bit_cast(bf16x8, w);
}
__device__ __forceinline__ unsigned lds_ld(volatile LAS unsigned* p) { return *p; }
__device__ __forceinline__ void gla_chunk_rows(int c, int b, int dir, bool& isctx, int& rbase) {
    isctx = c < 4;
    const int ci = (dir == 0) ? (isctx ? c : c - 4) : (isctx ? 3 - c : 31 - (c - 4));
    const int base_row = isctx ? MLAT + b * 256 + ci * 64 : b * 2048 + ci * 64;
    rbase = dir ? base_row + 63 : base_row;
}
__device__ __forceinline__ void gla_prep(const bf16* Z, int b, int h, int dir, int it, LAS unsigned char* L, int lane) {
    LAS unsigned char* gim = L + it * 15616; LAS unsigned char* qim = gim + 6144; LAS unsigned char* kri = qim + 4608; LAS float* evp = (LAS float*)(kri + 4608);
    volatile LAS unsigned* flag = (volatile LAS unsigned*)(L + GL_FLAG);
    const int r = lane & 31, hh = lane >> 5, rh = (lane >> 4) & 1, qq = (lane & 15) >> 2, p4 = lane & 3;
    const int gcol = (dir ? ZC_GB : ZC_GF) + h * 64, qcol = ZC_GQ + h * 64, kcol = ZC_GK + h * 64;
    const int a_off = qq * GIM_STRIDE + (16 * rh + 4 * p4) * 2;
    const __amdgpu_buffer_rsrc_t zrs = __builtin_amdgcn_make_buffer_rsrc((void*)Z, 0, (int)((size_t)MTOT * NZ * 2), 0x00020000);
    const int vo8 = (dir ? 7 - (lane >> 3) : (lane >> 3)) * (NZ * 2) + (lane & 7) * 16;
    v4u gld[4], qld[4], kld[4];
#define GLA_LOAD_RAW(cc) do { bool ic_; int rb_; gla_chunk_rows((cc), b, dir, ic_, rb_); _Pragma("unroll") for (int i = 0; i < 4; ++i) { const int p0 = 32 * it + 8 * i; const int so = (dir ? rb_ - p0 - 7 : rb_ + p0) * (NZ * 2); \
        gld[i] = __builtin_amdgcn_raw_buffer_load_b128(zrs, vo8, so + gcol * 2, 0); qld[i] = __builtin_amdgcn_raw_buffer_load_b128(zrs, vo8, so + qcol * 2, 0); kld[i] = __builtin_amdgcn_raw_buffer_load_b128(zrs, vo8, so + kcol * 2, 0); } } while (0)
    GLA_LOAD_RAW(0);
    for (int c = 0; c < 36; ++c) {
#pragma unroll
        for (int i = 0; i < 4; ++i) { *(LAS v4u*)(gim + (8 * i + (lane >> 3)) * GIM_STRIDE + (lane & 7) * 16) = gld[i];
            *(LAS v4u*)(qim + (8 * i + (lane >> 3)) * 144 + (lane & 7) * 16) = qld[i]; *(LAS v4u*)(kri + (8 * i + (lane >> 3)) * 144 + (lane & 7) * 16) = kld[i]; }
        if (c + 1 < 36) GLA_LOAD_RAW(c + 1);
        bf16x8 mm[2], mr;
#pragma unroll
        for (int s = 0; s < 2; ++s)
#pragma unroll
            for (int jj = 0; jj < 8; ++jj) { const int j = 16 * s + 8 * hh + jj; mm[s][jj] = (it == 0) ? ((j > r) ? (short)0xBF80 : (short)0) : ((j <= r) ? (short)0x3F80 : (short)0); }
#pragma unroll
        for (int jj = 0; jj < 8; ++jj) mr[jj] = (r == 0) ? (short)0x3F80 : (short)0;
        bf16x8 qf[2][2], kf[2][2];
#pragma unroll
        for (int dt = 0; dt < 2; ++dt) {
            bf16x8 ga[2];
#pragma unroll
            for (int s = 0; s < 2; ++s) { const LAS unsigned char* p = gim + (16 * s + 8 * hh) * GIM_STRIDE + dt * 64 + a_off; ga[s] = mk8(trr(p), trr(p + 4 * GIM_STRIDE)); }
            f32x16 z16;
#pragma unroll
            for (int i = 0; i < 16; ++i) z16[i] = 0.f;
            f32x16 C = MFMA32(ga[0], mm[0], z16); C = MFMA32(ga[1], mm[1], C);
            if (it == 0) {
                f32x16 R = MFMA32(ga[0], mr, z16); R = MFMA32(ga[1], mr, R);
                if (r == 0) {
#pragma unroll
                    for (int g = 0; g < 4; ++g) *(LAS f32x4*)(evp + 32 * dt + 8 * g + 4 * hh) = (f32x4){ex2(R[4 * g]), ex2(R[4 * g + 1]), ex2(R[4 * g + 2]), ex2(R[4 * g + 3])};
                }
            } else if (r == 31) {
#pragma unroll
                for (int g = 0; g < 4; ++g) *(LAS f32x4*)(evp + 32 * dt + 8 * g + 4 * hh) = (f32x4){ex2(C[4 * g]), ex2(C[4 * g + 1]), ex2(C[4 * g + 2]), ex2(C[4 * g + 3])};
            }
            f32x16 qt, kt;
#pragma unroll
            for (int g = 0; g < 4; ++g) {
                const v2u qw = *(const LAS v2u*)(qim + r * 144 + (32 * dt + 8 * g + 4 * hh) * 2), kw = *(const LAS v2u*)(kri + r * 144 + (32 * dt + 8 * g + 4 * hh) * 2);
                const float qv[4] = {bflo(qw.x), bfhi(qw.x), bflo(qw.y), bfhi(qw.y)}, kv[4] = {bflo(kw.x), bfhi(kw.x), bflo(kw.y), bfhi(kw.y)};
#pragma unroll
                for (int e = 0; e < 4; ++e) { const float cc = C[4 * g + e]; const float eq = ex2(cc), ek = ex2(-cc);
                    qt[4 * g + e] = qv[e] * eq * 0.125f; kt[4 * g + e] = kv[e] * ek; }
            }
            qf[dt][0] = pack8(qt, 0); qf[dt][1] = pack8(qt, 1); kf[dt][0] = pack8(kt, 0); kf[dt][1] = pack8(kt, 1);
        }
        const int bsel = c & 1; LAS unsigned char* sb = L + GL_SB + bsel * GL_SBSZ;
        { unsigned spins = 0;
          for (;;) { const unsigned d0 = lds_ld(flag + 4 + 4 * bsel), d1 = lds_ld(flag + 5 + 4 * bsel), d2 = lds_ld(flag + 6 + 4 * bsel), d3 = lds_ld(flag + 7 + 4 * bsel);
              const unsigned need = (unsigned)(c > 1 ? c - 1 : 0);
              if ((d0 >= need && d1 >= need && d2 >= need && d3 >= need) || ++spins > GL_SPIN_CAP) break; __builtin_amdgcn_s_sleep(1); } }
        asm volatile("" ::: "memory");
#pragma unroll
        for (int dt = 0; dt < 2; ++dt)
#pragma unroll
            for (int s = 0; s < 2; ++s) {
                *(LAS bf16x8*)(sb + GL_QF + ((it * 2 + dt) * 2 + s) * 1024 + lane * 16) = qf[dt][s]; *(LAS bf16x8*)(sb + GL_KF + ((it * 2 + dt) * 2 + s) * 1024 + lane * 16) = kf[dt][s];
                const v4u w = __builtin_bit_cast(v4u, kf[dt][s]); LAS unsigned char* p = sb + GL_KIM + (r + 32 * it) * GIM_STRIDE + (32 * dt + 16 * s + 4 * hh) * 2;
                *(LAS v2u*)p = (v2u){w.x, w.y}; *(LAS v2u*)(p + 16) = (v2u){w.z, w.w}; }
        ((LAS float*)(sb + GL_EV))[64 * it + lane] = evp[lane];
        asm volatile("s_waitcnt lgkmcnt(0)" ::: "memory");
        if (lane == 0) flag[2 * bsel + it] = (unsigned)(c + 1);
        asm volatile("" ::: "memory");
    }
#undef GLA_LOAD_RAW
}
__device__ __forceinline__ void gla_scan(const bf16* Z, bf16* OG, int b, int h, int dir, int sl, bool last, LAS unsigned char* L, int lane) {
    LAS unsigned char* vim = L + GL_VIM + sl * 4096; volatile LAS unsigned* flag = (volatile LAS unsigned*)(L + GL_FLAG);
    const int r = lane & 31, hh = lane >> 5, rh = (lane >> 4) & 1, qq = (lane & 15) >> 2, p4 = lane & 3;
    const int vcol = ZC_GV + h * 128 + 32 * sl;
    const int a_off = qq * GIM_STRIDE + (16 * rh + 4 * p4) * 2;
    const int v_off = qq * 64 + (16 * rh + 4 * p4) * 2;
    const __amdgpu_buffer_rsrc_t zrs = __builtin_amdgcn_make_buffer_rsrc((void*)Z, 0, (int)((size_t)MTOT * NZ * 2), 0x00020000);
    const __amdgpu_buffer_rsrc_t ors = __builtin_amdgcn_make_buffer_rsrc((void*)(OG + (size_t)dir * MTOT * 512), 0, MTOT * 512 * 2, 0x00020000);
    const int vo16 = (dir ? 15 - (lane >> 2) : (lane >> 2)) * (NZ * 2) + (lane & 3) * 16;
    const int voo2 = (dir ? 31 - 16 * rh - (lane & 15) : 16 * rh + (lane & 15)) * 1024 + (h * 128 + 32 * sl + 16 * hh) * 2;
    f32x16 S[2];
#pragma unroll
    for (int i = 0; i < 16; ++i) { S[0][i] = 0.f; S[1][i] = 0.f; }
    v4u vld[4];
#define GLA_LOAD_V(cc) do { bool ic_; int rb_; gla_chunk_rows((cc), b, dir, ic_, rb_); _Pragma("unroll") for (int i = 0; i < 4; ++i) \
        vld[i] = __builtin_amdgcn_raw_buffer_load_b128(zrs, vo16, (dir ? rb_ - 16 * i - 15 : rb_ + 16 * i) * (NZ * 2) + vcol * 2, 0); } while (0)
    GLA_LOAD_V(0);
    for (int c = 0; c < 36; ++c) {
        bool isctx; int rbase; gla_chunk_rows(c, b, dir, isctx, rbase);
#pragma unroll
        for (int i = 0; i < 4; ++i) *(LAS v4u*)(vim + (16 * i + (lane >> 2)) * 64 + (lane & 3) * 16) = vld[i];
        if (c + 1 < 36) GLA_LOAD_V(c + 1);
        bf16x8 vf[2][2];
#pragma unroll
        for (int jt = 0; jt < 2; ++jt)
#pragma unroll
            for (int s = 0; s < 2; ++s) { const LAS unsigned char* p = vim + (32 * jt + 16 * s + 4 * hh) * 64 + v_off; vf[jt][s] = mk8(trr(p), trr(p + 8 * 64)); }
        const int bsel = c & 1; const LAS unsigned char* sb = L + GL_SB + bsel * GL_SBSZ;
        { unsigned spins = 0; while (lds_ld(flag + 12 + bsel) < (unsigned)(c + 1) && ++spins <= GL_SPIN_CAP) __builtin_amdgcn_s_sleep(1); }
        asm volatile("" ::: "memory");
        const LAS float* evec = (const LAS float*)(sb + GL_EV);
#pragma unroll
        for (int dt = 0; dt < 2; ++dt)
#pragma unroll
            for (int g = 0; g < 4; ++g) { const f32x4 e4 = *(const LAS f32x4*)(evec + 32 * dt + 8 * g + 4 * hh);
#pragma unroll
                for (int e = 0; e < 4; ++e) S[dt][4 * g + e] *= e4[e]; }
        bf16x8 sf[2][2];
#pragma unroll
        for (int dt = 0; dt < 2; ++dt) { sf[dt][0] = pack8(S[dt], 0); sf[dt][1] = pack8(S[dt], 1); }
#pragma unroll
        for (int it = 0; it < 2; ++it) {
            f32x16 acc;
#pragma unroll
            for (int i = 0; i < 16; ++i) acc[i] = 0.f;
#pragma unroll
            for (int dt = 0; dt < 2; ++dt)
#pragma unroll
                for (int s = 0; s < 2; ++s) acc = MFMA32(*(const LAS bf16x8*)(sb + GL_QF + ((it * 2 + dt) * 2 + s) * 1024 + lane * 16), sf[dt][s], acc);
#pragma unroll
            for (int jt = 0; jt <= it; ++jt) {
                const LAS unsigned char* xp = sb + GL_XF + (it + jt) * 2048 + lane * 16;
                acc = MFMA32(*(const LAS bf16x8*)xp, vf[jt][0], acc); acc = MFMA32(*(const LAS bf16x8*)(xp + 1024), vf[jt][1], acc);
            }
            if (!(isctx && last)) {
#pragma unroll
                for (int g = 0; g < 4; ++g) *(LAS v2u*)(vim + r * 64 + 8 * (2 * g + hh)) = (v2u){cvtpk(acc[4 * g], acc[4 * g + 1]), cvtpk(acc[4 * g + 2], acc[4 * g + 3])};
                const int ph = rh, dh = hh;
                v2u t4[4];
#pragma unroll
                for (int a = 0; a < 4; ++a) t4[a] = __builtin_bit_cast(v2u, trr(vim + (16 * dh + 4 * a + qq) * 64 + 32 * ph + 8 * p4));
                const int so = (dir ? rbase - 32 * it - 31 : rbase + 32 * it) * 1024;
                __builtin_amdgcn_raw_buffer_store_b128((v4u){t4[0].x, t4[0].y, t4[1].x, t4[1].y}, ors, voo2, so, 0);
                __builtin_amdgcn_raw_buffer_store_b128((v4u){t4[2].x, t4[2].y, t4[3].x, t4[3].y}, ors, voo2 + 16, so, 0);
            }
        }
#pragma unroll
        for (int dt = 0; dt < 2; ++dt) {
#pragma unroll
            for (int jt = 0; jt < 2; ++jt)
#pragma unroll
                for (int s = 0; s < 2; ++s) { const LAS unsigned char* p = sb + GL_KIM + (32 * jt + 16 * s + 4 * hh) * GIM_STRIDE + dt * 64 + a_off; S[dt] = MFMA32(mk8(trr(p), trr(p + 8 * GIM_STRIDE)), vf[jt][s], S[dt]); }
#pragma unroll
            for (int g = 0; g < 4; ++g) { const f32x4 e4 = *(const LAS f32x4*)(evec + 64 + 32 * dt + 8 * g + 4 * hh);
#pragma unroll
                for (int e = 0; e < 4; ++e) S[dt][4 * g + e] *= e4[e]; }
        }
        asm volatile("s_waitcnt lgkmcnt(0)" ::: "memory");
        if (lane == 0) flag[4 + 4 * bsel + sl] = (unsigned)(c + 1);
        asm volatile("" ::: "memory");
    }
#undef GLA_LOAD_V
}
__device__ __forceinline__ void gla_xwave(LAS unsigned char* L, int lane) {
    volatile LAS unsigned* flag = (volatile LAS unsigned*)(L + GL_FLAG);
    const int r = lane & 31, hh = lane >> 5;
    for (int c = 0; c < 36; ++c) {
        const int bsel = c & 1; LAS unsigned char* sb = L + GL_SB + bsel * GL_SBSZ;
        { unsigned spins = 0; while ((lds_ld(flag + 2 * bsel) < (unsigned)(c + 1) || lds_ld(flag + 2 * bsel + 1) < (unsigned)(c + 1)) && ++spins <= GL_SPIN_CAP) __builtin_amdgcn_s_sleep(1); }
        asm volatile("" ::: "memory");
#pragma unroll
        for (int t = 0; t < 3; ++t) {
            const int jt = t >> 1, it = (t + 1) >> 1;
            f32x16 x;
#pragma unroll
            for (int i = 0; i < 16; ++i) x[i] = 0.f;
#pragma unroll
            for (int dt = 0; dt < 2; ++dt)
#pragma unroll
                for (int s = 0; s < 2; ++s) x = MFMA32(*(const LAS bf16x8*)(sb + GL_KF + ((jt * 2 + dt) * 2 + s) * 1024 + lane * 16), *(const LAS bf16x8*)(sb + GL_QF + ((it * 2 + dt) * 2 + s) * 1024 + lane * 16), x);
            if (jt == it) {
#pragma unroll
                for (int i = 0; i < 16; ++i) { const int jrow = (i & 3) + 8 * (i >> 2) + 4 * hh; x[i] = (jrow <= r) ? x[i] : 0.f; }
            }
            *(LAS bf16x8*)(sb + GL_XF + t * 2048 + lane * 16) = pack8(x, 0); *(LAS bf16x8*)(sb + GL_XF + t * 2048 + 1024 + lane * 16) = pack8(x, 1);
        }
        asm volatile("s_waitcnt lgkmcnt(0)" ::: "memory");
        if (lane == 0) flag[12 + bsel] = (unsigned)(c + 1);
        asm volatile("" ::: "memory");
    }
}

typedef const float* __attribute__((address_space(4))) const* karg_tab_t;
#define KIN(i) (F.karg[(i)])
#define KOUT() ((float*)(F.karg[20]))
struct Frame {
    LAS unsigned char* lds;
    int tid, lane, wave, vcu, G, bx;
    unsigned char* ws; karg_tab_t karg;
};
enum { I_X = 0, I_C, I_CTX, I_CCTX, I_WMOD, I_BMOD, I_N1G, I_N2G, I_WIN, I_RPB, I_SINK, I_GATEW, I_GATEB, I_GNORM, I_WOUT, I_WUP, I_CONVW, I_CONVB, I_WDN, I_FNG };

__device__ __forceinline__ void gemv64_item(Frame& F, const float* vp, int vstride, const float* vp8, bool do_silu, const float* W, int ldw, int col0, float* out, int ostride, const float* addb) {
    LAS float* tab = (LAS float*)F.lds; LAS float* red = (LAS float*)(F.lds + 36864);
    __syncthreads();
#pragma unroll 1
    for (int hb = 0; hb < 2; ++hb) {
        float tv[9];
#pragma unroll
        for (int j = 0; j < 9; ++j) { const int i = F.tid + NTHREADS * (9 * hb + j), s = i >> 10, k = i & 1023; tv[j] = (s < 8) ? vp[(size_t)s * vstride + k] : vp8[k]; }
#pragma unroll
        for (int j = 0; j < 9; ++j) { float v = tv[j]; if (do_silu) v = v / (1.0f + expf(-v)); tab[F.tid + NTHREADS * (9 * hb + j)] = v; }
    }
    __syncthreads();
    const int rq = F.lane >> 4, cq = F.lane & 15;
    f32x4 acc[9];
#pragma unroll
    for (int s = 0; s < 9; ++s) acc[s] = (f32x4){0.f, 0.f, 0.f, 0.f};
    const float* wp = W + (size_t)(F.wave * 128 + rq) * ldw + col0 + 4 * cq;
    const LAS float* tp = tab + F.wave * 128 + rq;
#pragma unroll 1
    for (int k0 = 0; k0 < 128; k0 += 64) {
        f32x4 wv[16];
#pragma unroll
        for (int u = 0; u < 16; ++u) wv[u] = *(const f32x4*)(wp + (size_t)(k0 + 4 * u) * ldw);
#pragma unroll
        for (int u = 0; u < 16; ++u)
#pragma unroll
            for (int s = 0; s < 9; ++s) acc[s] += wv[u] * tp[s * 1024 + k0 + 4 * u]; }
#pragma unroll
    for (int s = 0; s < 9; ++s)
#pragma unroll
        for (int e = 0; e < 4; ++e) acc[s][e] = xsum_16_32(acc[s][e]);
    if (rq == 0) {
#pragma unroll
        for (int s = 0; s < 9; ++s) *(LAS f32x4*)(red + (F.wave * 9 + s) * 64 + 4 * cq) = acc[s];
    }
    __syncthreads();
    for (int i = F.tid; i < 576; i += NTHREADS) { const int s = i >> 6, n = i & 63; float t = 0.f;
#pragma unroll
        for (int w = 0; w < 8; ++w) t += red[(w * 9 + s) * 64 + n];
        if (addb) t += addb[col0 + n];
        out[(size_t)s * ostride + col0 + n] = t; }
}
__device__ __forceinline__ int in_rowmap(int c) { if (c < 768 || c >= 1152) return c; const int hb = c & ~63, d = c & 63; return hb + ((d & 31) >> 2) * 8 + ((d >> 5) << 2) + (d & 3); }
__device__ __forceinline__ int up_rowmap(int c) { const int gate = c >= FFD ? 1 : 0, f = c - gate * FFD; return ((f >> 7) << 8) + (gate << 7) + (f & 127); }
template <int MAP> __device__ __forceinline__ void transpose_item(const float* W, int ldw, int nblk, bf16* WT, int K, int row_off, LAS float* scr, int item, int lane) {
    const int kb = item / nblk, nb = item % nblk, k0 = 64 * kb, n0 = 32 * nb;
    f32x4 ld[8];
#pragma unroll
    for (int j = 0; j < 8; ++j) ld[j] = *(const f32x4*)(W + (size_t)(k0 + 8 * j + (lane >> 3)) * ldw + n0 + 4 * (lane & 7));
#pragma unroll
    for (int j = 0; j < 8; ++j) { LAS float* d = scr + (8 * j + (lane >> 3)) * 33 + 4 * (lane & 7); d[0] = ld[j][0]; d[1] = ld[j][1]; d[2] = ld[j][2]; d[3] = ld[j][3]; }
    LDS_WAIT(); asm volatile("" ::: "memory");
    const int c = lane & 7;
#pragma unroll
    for (int j = 0; j < 4; ++j) { const int n = (lane >> 3) + 8 * j; const LAS float* s = scr + (8 * c) * 33 + n;
        v4u o; o.x = pk2(s[0 * 33], s[1 * 33]); o.y = pk2(s[2 * 33], s[3 * 33]); o.z = pk2(s[4 * 33], s[5 * 33]); o.w = pk2(s[6 * 33], s[7 * 33]);
        *(v4u*)(WT + (size_t)(row_off + (MAP == 1 ? in_rowmap(n0 + n) : (MAP == 2 ? up_rowmap(n0 + n) : n0 + n))) * K + k0 + 8 * c) = o; }
    LDS_WAIT(); asm volatile("" ::: "memory");
}

constexpr int CV_IN = 16 * 88, CV_OUT = 16 * 32, CV_UP = 16 * 176, CV_DN = 44 * 32, CV_ALL = CV_IN + CV_OUT + CV_UP + CV_DN;
__device__ __forceinline__ void convert_range(Frame& F, int l, int lo, int hi, int gw, int ngw) {
    LAS float* scr = (LAS float*)(F.lds + 57344 + F.wave * 8448);
    for (int it = lo + gw; it < hi; it += ngw) {
        int r = it;
        if (r < CV_IN) { transpose_item<1>(KIN(I_WIN) + (size_t)l * 1024 * NINSRC, NINSRC, 88, (bf16*)(F.ws + WS_WIN) + (size_t)l * NZ * 1024, 1024, 0, scr, r, F.lane); continue; } r -= CV_IN;
        if (r < CV_OUT) { transpose_item<0>(KIN(I_WOUT) + (size_t)l * 1024 * 1024, 1024, 32, (bf16*)(F.ws + WS_WOUT) + (size_t)l * 1024 * 1024, 1024, 0, scr, r, F.lane); continue; } r -= CV_OUT;
        if (r < CV_UP) { transpose_item<2>(KIN(I_WUP) + (size_t)l * 1024 * NUP, NUP, 176, (bf16*)(F.ws + WS_WUP) + (size_t)l * NUP * 1024, 1024, 0, scr, r, F.lane); continue; } r -= CV_UP;
        transpose_item<0>(KIN(I_WDN) + (size_t)l * FFD * 1024, 1024, 32, (bf16*)(F.ws + WS_WDN) + (size_t)l * 1024 * FFD, FFD, 0, scr, r, F.lane);
    }
}
__device__ __forceinline__ void gate_fold(Frame& F, int l, int t0, int nt);
__device__ __forceinline__ void phase_p0a(Frame& F) {
    float* mod = (float*)(F.ws + WS_MOD);
    for (int it = F.vcu; it < 2 * 96; it += F.G) {
        const int l = it / 96, cg = it % 96;
        gemv64_item(F, KIN(I_C), 1024, KIN(I_CCTX), true, KIN(I_WMOD) + (size_t)l * 1024 * MODW, MODW, cg * 64, mod + (size_t)l * NSEG * MODW, MODW, KIN(I_BMOD) + (size_t)l * MODW);
    }
    __syncthreads();
    convert_range(F, 0, 0, CV_IN + CV_OUT, F.vcu * NWAVES + F.wave, F.G * NWAVES);
    { float* cosT = (float*)(F.ws + WS_ROPE); float* sinT = cosT + 2048 * 32;
      for (int idx = F.vcu * NTHREADS + F.tid; idx < 2048 * 32; idx += F.G * NTHREADS) { const int t = idx >> 5, d = idx & 31, f = d & 15; const float pos = (d < 16) ? (float)(t >> 6) : (float)(t & 63);
          const float inv = powf(10000.0f, -(float)f / 16.0f); const float ang = pos * inv; cosT[idx] = cosf(ang); sinT[idx] = sinf(ang); } }
    gate_fold(F, 0, F.vcu * NTHREADS + F.tid, F.G * NTHREADS);
}
__device__ __forceinline__ void gate_fold(Frame& F, int l, int t0, int nt) {
    for (int idx = t0; idx < 2 * 256 * 128; idx += nt) {
        const int n = idx & 255, kg = (idx >> 8) & 127, dir = (idx >> 15) & 1;
        const float* wi = KIN(I_WIN) + (size_t)l * 1024 * NINSRC + (size_t)(kg * 8) * NINSRC + 2816 + 16 * dir;
        const float* gw_ = KIN(I_GATEW) + (size_t)((l * 2 + dir) * 16) * 256 + n;
        float g[16];
#pragma unroll
        for (int j = 0; j < 16; ++j) g[j] = gw_[j * 256];
        float r[8];
#pragma unroll
        for (int kk = 0; kk < 8; ++kk) { const f32x4* wr4 = (const f32x4*)(wi + (size_t)kk * NINSRC); float a = 0.f;
#pragma unroll
            for (int q = 0; q < 4; ++q) { const f32x4 w4 = wr4[q]; a += w4[0] * g[4 * q] + w4[1] * g[4 * q + 1] + w4[2] * g[4 * q + 2] + w4[3] * g[4 * q + 3]; }
            r[kk] = a; }
        v4u o; o.x = pk2(r[0], r[1]); o.y = pk2(r[2], r[3]); o.z = pk2(r[4], r[5]); o.w = pk2(r[6], r[7]);
        *(v4u*)((bf16*)(F.ws + WS_WIN) + (size_t)l * NZ * 1024 + (size_t)(2816 + 256 * dir + n) * 1024 + kg * 8) = o;
    }
}

__device__ __forceinline__ void bias_items(Frame& F, int lo, int hi, int blk, int nblk) {
    const float* mod = (const float*)(F.ws + WS_MOD);
    float* bin = (float*)(F.ws + WS_BIN); float* bup = (float*)(F.ws + WS_BUP);
    for (int it = lo + blk; it < hi; it += nblk) {
        int l, r;
        if (it < 44) { l = 0; r = it; } else if (it < 46) { l = 0; r = 132 + (it - 44); } else if (it < 134) { l = 0; r = 44 + (it - 46); } else { l = 1; r = it - 134; }
        const float* modl = mod + (size_t)l * NSEG * MODW;
        if (r < 44) { gemv64_item(F, modl + 0, MODW, modl + 8 * MODW + 0, false, KIN(I_WIN) + (size_t)l * 1024 * NINSRC, NINSRC, r * 64, bin + (size_t)l * NSEG * NZ, NZ, nullptr); continue; } r -= 44;
        if (r < 88) { gemv64_item(F, modl + 3072, MODW, modl + 8 * MODW + 3072, false, KIN(I_WUP) + (size_t)l * 1024 * NUP, NUP, r * 64, bup + (size_t)l * NSEG * NUP, NUP, nullptr); continue; } r -= 88;
        {
            const int dir = r;
            LAS float* part = (LAS float*)F.lds;
            LAS float* T = (LAS float*)(F.lds + 4096);
            __syncthreads();
            {
                const int j = F.tid & 15, ks = F.tid >> 4;
                const float* wi = KIN(I_WIN) + (size_t)l * 1024 * NINSRC + (size_t)(ks * 32) * NINSRC + 2816 + 16 * dir + j;
                float wv[32];
#pragma unroll
                for (int u = 0; u < 32; ++u) wv[u] = wi[(size_t)u * NINSRC];
                float acc[9];
#pragma unroll
                for (int s = 0; s < 9; ++s) { const float* sh = modl + (size_t)s * MODW + ks * 32; float a = 0.f;
#pragma unroll
                    for (int u = 0; u < 32; ++u) a += sh[u] * wv[u];
                    acc[s] = a; }
                LAS float* part2 = (LAS float*)(F.lds + 8192);
#pragma unroll
                for (int s = 0; s < 9; ++s) part2[ks * 144 + s * 16 + j] = acc[s];
            }
            __syncthreads();
            if (F.tid < 144) { const LAS float* part2 = (const LAS float*)(F.lds + 8192); float t = 0.f;
#pragma unroll
                for (int ks = 0; ks < 32; ++ks) t += part2[ks * 144 + F.tid];
                T[F.tid] = t; }
            __syncthreads();
            for (int i = F.tid; i < 9 * 256; i += NTHREADS) { const int s = i >> 8, n = i & 255;
                const float* gw_ = KIN(I_GATEW) + (size_t)((l * 2 + dir) * 16) * 256 + n; float a = KIN(I_GATEB)[(l * 2 + dir) * 256 + n];
#pragma unroll
                for (int j = 0; j < 16; ++j) a += T[s * 16 + j] * gw_[j * 256];
                bin[(size_t)l * NSEG * NZ + (size_t)s * NZ + 2816 + 256 * dir + n] = a; }
        }
    }
}
__device__ __forceinline__ void phase_p0b(Frame& F) {
    const float* mod = (const float*)(F.ws + WS_MOD);
    bias_items(F, 0, 46, F.vcu, F.G);
    const int gw = F.vcu * NWAVES + F.wave, NGW = F.G * NWAVES;
    bf16* XM = (bf16*)(F.ws + WS_XM); float* ssq = (float*)(F.ws + WS_SSQB);
    const int ngrp = MTOT / 4, nfirst = 2 * NGW < ngrp ? 2 * NGW : ngrp; const int gw2 = (F.vcu - 46) * NWAVES + F.wave, NGW2 = (F.G - 46) * NWAVES;
    for (int it = 0; it < 3; ++it) {
        int grp; if (it < 2) grp = gw + it * NGW; else grp = (F.vcu >= 46) ? nfirst + gw2 : ngrp;
        if (it < 2 ? grp >= nfirst : grp >= ngrp) continue;
        const int row0 = grp * 4;
        const int seg = pg8::seg_of(row0);
        const float* sc1 = mod + (size_t)seg * MODW + 1024; const float* g1 = KIN(I_N1G);
        f32x4 xv[4][4];
#pragma unroll
        for (int u = 0; u < 4; ++u) { const int row = row0 + u; const float* src = row < MLAT ? KIN(I_X) + (size_t)row * 1024 : KIN(I_CTX) + (size_t)(row - MLAT) * 1024;
#pragma unroll
            for (int j = 0; j < 4; ++j) xv[u][j] = *(const f32x4*)(src + 8 * (F.lane + 64 * (j >> 1)) + 4 * (j & 1)); }
        f32x4 gm[4];
#pragma unroll
        for (int j = 0; j < 4; ++j) { const int k = 8 * (F.lane + 64 * (j >> 1)) + 4 * (j & 1); gm[j] = *(const f32x4*)(g1 + k) * (*(const f32x4*)(sc1 + k) + 1.0f); }
#pragma unroll
        for (int u = 0; u < 4; ++u) { const int row = row0 + u; float ss = 0.f;
#pragma unroll
            for (int jj = 0; jj < 2; ++jj) { const int k = 8 * (F.lane + 64 * jj); const f32x4 x0 = xv[u][2 * jj], x1 = xv[u][2 * jj + 1];
                ss += ((x0[0] * x0[0] + x0[1] * x0[1]) + (x0[2] * x0[2] + x0[3] * x0[3])) + ((x1[0] * x1[0] + x1[1] * x1[1]) + (x1[2] * x1[2] + x1[3] * x1[3]));
                const f32x4 m0 = x0 * gm[2 * jj], m1 = x1 * gm[2 * jj + 1];
                *(v4u*)(XM + (size_t)row * 1024 + k) = (v4u){pk2(m0[0], m0[1]), pk2(m0[2], m0[3]), pk2(m1[0], m1[1]), pk2(m1[2], m1[3])}; }
            ss = wave_sum(ss, F.lane);
            if (F.lane == 0) ssq[row] = ss; }
    }
}

__device__ __forceinline__ void phase_mixer(Frame& F, int l, bool last) {
    const bf16* Z = (const bf16*)(F.ws + WS_Z); bf16* Y = (bf16*)(F.ws + WS_Y); bf16* OG = (bf16*)(F.ws + WS_XM);
    constexpr int RPB_OFF = 136960;
    LAS float* rpbL = (LAS float*)(F.lds + RPB_OFF);
    { const float* rpb = KIN(I_RPB) + (size_t)l * 4 * 15 * 31; float rv[4];
#pragma unroll
      for (int j = 0; j < 4; ++j) { const int i = F.tid + NTHREADS * j, rw = i >> 5, cl = i & 31; rv[j] = (i < 4 * 15 * 32 && cl < 31) ? rpb[rw * 31 + cl] : 0.f; }
#pragma unroll
      for (int j = 0; j < 4; ++j) { const int i = F.tid + NTHREADS * j, cl = i & 31; if (i < 4 * 15 * 32) rpbL[i] = (cl < 31) ? rv[j] * LOG2E : -INFINITY; } }
    if (F.tid < 64) ((LAS unsigned*)(F.lds + GL_FLAG))[F.tid] = 0u;
    __syncthreads();
    const int xg = F.vcu >> 5, xl = F.vcu & 31;
    const bool glawg = xl < 8;
    if (glawg && F.wave < 7) {
        const int b = xg, h = xl >> 1, dir = xl & 1;
        if (F.wave < 4) { __builtin_amdgcn_s_setprio(3); gla_scan(Z, OG, b, h, dir, F.wave, last, F.lds, F.lane); }
        else if (F.wave == 6) { __builtin_amdgcn_s_setprio(2); gla_xwave(F.lds, F.lane); }
        else { __builtin_amdgcn_s_setprio(1); if (F.wave == 4) gla_prep(Z, b, h, dir, 0, F.lds, F.lane); else gla_prep(Z, b, h, dir, 1, F.lds, F.lane); }
        __builtin_amdgcn_s_setprio(0);
        return;
    }
    if (glawg) return;
    const float* sink = KIN(I_SINK) + l * 4;
    const int nblk = last ? 16 : 18;
    unsigned* qctr = (unsigned*)(F.ws + WS_CTL) + CW_QUEUE + (l * 8 + xg) * 64;
    volatile LAS int* itw = (volatile LAS int*)(F.lds + AT_RING);
    for (;;) {
        if (F.tid == 0) *itw = (int)__hip_atomic_fetch_add(qctr, 1u, __ATOMIC_RELAXED, __HIP_MEMORY_SCOPE_AGENT);
        asm volatile("s_waitcnt vmcnt(0) lgkmcnt(0)" ::: "memory"); __builtin_amdgcn_s_barrier(); asm volatile("" ::: "memory");
        const int it = __builtin_amdgcn_readfirstlane(*itw);
        if (it >= nblk * 6) break;
        if (it < nblk * 2) wa_block(Z, Y, sink, F.lds, F.lane, F.wave, xg, it >> 1, it & 1);
        else { const int k = it - nblk * 2; na_block(Z, Y, rpbL, F.lds, F.lane, F.wave, xg, k >> 2, k & 3); }
    }
}
__device__ __forceinline__ void phase_gla_finish(Frame& F, int l, bool last) {
    const bf16* Z = (const bf16*)(F.ws + WS_Z); bf16* Y = (bf16*)(F.ws + WS_Y); const bf16* OG = (const bf16*)(F.ws + WS_XM);
    const float* gnorm = KIN(I_GNORM) + l * 128;
    const int lane = F.lane; const float gn0 = gnorm[2 * lane], gn1 = gnorm[2 * lane + 1];
    const int nrows = last ? MLAT : MTOT, ngrp = nrows / 8 * 4;
    const int gw = F.vcu * NWAVES + F.wave, NGW = F.G * NWAVES;
    for (int gi = gw; gi < ngrp; gi += NGW) {
        const int h = gi & 3, r0 = (gi >> 2) * 8;
        unsigned wf[8], wb[8], wg[8];
#pragma unroll
        for (int u = 0; u < 8; ++u) { const size_t row = (size_t)(r0 + u);
            wf[u] = *(const unsigned*)(OG + row * 512 + h * 128 + 2 * lane); wb[u] = *(const unsigned*)(OG + (size_t)MTOT * 512 + row * 512 + h * 128 + 2 * lane);
            wg[u] = *(const unsigned*)(Z + row * NZ + ZC_GO + h * 128 + 2 * lane); }
#pragma unroll
        for (int u = 0; u < 8; ++u) {
            const float x0 = bflo(wf[u]) + bflo(wb[u]), x1 = bfhi(wf[u]) + bfhi(wb[u]);
            const float ss = wave_sum(x0 * x0 + x1 * x1, lane); const float ri = 1.0f / sqrtf(ss * (1.0f / 128.0f) + 1e-6f);
            const float g0 = bflo(wg[u]), g1 = bfhi(wg[u]);
            const float y0 = x0 * ri * gn0 * (g0 / (1.0f + expf(-g0))), y1 = x1 * ri * gn1 * (g1 / (1.0f + expf(-g1)));
            *(unsigned*)(Y + (size_t)(r0 + u) * 1024 + 512 + h * 128 + 2 * lane) = pk2(y0, y1);
        }
    }
}

__device__ __forceinline__ void phase_final(Frame& F) {
    const int gw = F.vcu * NWAVES + F.wave, NGW = F.G * NWAVES; const float* ssq = (const float*)(F.ws + WS_SSQB); const float* fg = KIN(I_FNG); const bf16* XB = (const bf16*)(F.ws + WS_XM);
    f32x4 gv[2][2];
#pragma unroll
    for (int j = 0; j < 2; ++j) { const int k = 8 * (F.lane + 64 * j); gv[j][0] = *(const f32x4*)(fg + k); gv[j][1] = *(const f32x4*)(fg + k + 4); }
    for (int row0 = gw * 4; row0 < MLAT; row0 += NGW * 4) {
        v4u w[4][2]; float sq[4];
#pragma unroll
        for (int u = 0; u < 4; ++u) { const bf16* q = XB + (size_t)(row0 + u) * 1024; sq[u] = ssq[row0 + u];
#pragma unroll
            for (int j = 0; j < 2; ++j) w[u][j] = *(const v4u*)(q + 8 * (F.lane + 64 * j)); }
#pragma unroll
        for (int u = 0; u < 4; ++u) { const float ri = 1.0f / sqrtf(sq[u] * (1.0f / 1024.0f) + 1e-6f); float* p = KOUT() + (size_t)(row0 + u) * 1024;
#pragma unroll
            for (int j = 0; j < 2; ++j) { const int k = 8 * (F.lane + 64 * j); const v4u ww = w[u][j];
                const f32x4 x0 = {bflo(ww.x), bfhi(ww.x), bflo(ww.y), bfhi(ww.y)}, x1 = {bflo(ww.z), bfhi(ww.z), bflo(ww.w), bfhi(ww.w)};
                *(f32x4*)(p + k) = x0 * ri * gv[j][0]; *(f32x4*)(p + k + 4) = x1 * ri * gv[j][1]; } }
    }
}

struct Args { const float* in[20]; float* out; unsigned char* ws; int pad0, pad1; };
template <int PT> __device__ __forceinline__ void run_phase(int wave_id, LAS unsigned char* lds0, int l) {
    Frame F;
    { karg_tab_t kp = (karg_tab_t)__builtin_amdgcn_kernarg_segment_ptr(); asm volatile("; launder karg, phase %1" : "+s"(kp) : "i"(PT)); F.karg = kp; }
    { int w = wave_id; asm volatile("; launder wave, phase %1" : "+s"(w) : "i"(PT)); F.wave = w; }
    { unsigned ones = ~0u; asm volatile("; launder lane, phase %1" : "+s"(ones) : "i"(PT)); F.lane = __builtin_amdgcn_mbcnt_hi(ones, __builtin_amdgcn_mbcnt_lo(ones, 0u)); }
    F.tid = F.wave * 64 + F.lane;
    { int gx = gridDim.x, bx = blockIdx.x; asm volatile("; launder grid, phase %2" : "+s"(gx), "+s"(bx) : "i"(PT)); F.G = gx; F.bx = bx; F.vcu = (gx % 8 == 0) ? (bx % 8) * (gx / 8) + bx / 8 : bx; }
    F.ws = (unsigned char*)F.karg[21];
    { LAS unsigned char* lp = lds0; asm volatile("; launder lds, phase %1" : "+s"(lp) : "i"(PT)); F.lds = lp; }
    const bool last = (l == DEPTH - 1);
    float* modl = (float*)(F.ws + WS_MOD) + (size_t)l * NSEG * MODW;
    if constexpr (PT == 0) phase_p0a(F);
    else if constexpr (PT == 1) phase_p0b(F);
    else if constexpr (PT == 2) {
        pg8::EpiIn E{(pg8::bf16_t*)(F.ws + WS_Z), (const float*)(F.ws + WS_SSQB), (const float*)(F.ws + WS_BIN) + (size_t)l * NSEG * NZ, (const float*)(F.ws + WS_ROPE), 0};
        if (!last) {
            pg8::Gemm g{(const pg8::bf16_t*)(F.ws + WS_XM), (const pg8::bf16_t*)(F.ws + WS_WIN) + (size_t)l * NZ * 1024, MTOT, NZ, 1024, 256};
            pg8::StaticOrder S; S.init(MTOT, NZ, F.G, F.bx);
            pg8::gemm_phase<pg8::EpiIn, pg8::StaticOrder, true, true>(F.lds, g, S, E, F.tid);
        } else {
            pg8::Gemm g{(const pg8::bf16_t*)(F.ws + WS_XM), (const pg8::bf16_t*)(F.ws + WS_WIN) + (size_t)l * NZ * 1024, MLAT, NZ, 1024, 256};
            pg8::StaticOrder S; S.init(MLAT, NZ, F.G, F.bx);
            {
                struct Full3 { pg8::StaticOrder s; int lim;
                    __device__ __forceinline__ bool next(int i, pg8::Unit& u) const { if ((long)i * s.G + s.c >= lim) return false; return s.next(i, u); }
                    __device__ __forceinline__ void a_ready(const pg8::Unit&) const {} __device__ __forceinline__ void done(const pg8::Unit&) const {} };
                Full3 SF{S, (S.nwg / F.G) * F.G};
                pg8::gemm_phase<pg8::EpiIn, Full3, true, true>(F.lds, g, SF, E, F.tid);
            }
            {
                const int nfull = (S.nwg / F.G) * F.G, nrem = S.nwg - nfull, hu = F.bx >> 1, hm = F.bx & 1;
                pg8::Unit u; bool have = false;
                if (hu < nrem) { pg8::StaticOrder s1 = S; s1.c = nfull + hu; s1.G = 1 << 20; have = s1.next(0, u); }
                else if (hu - nrem < 64) { const int r = hu - nrem; const int cc = r & 7; u.pm = MLAT / 256 + (r >> 3); u.pn = cc == 0 ? 1 : cc == 1 ? 2 : cc == 2 ? 4 : cc == 3 ? 6 : cc == 4 ? 7 : cc == 5 ? 8 : cc == 6 ? 11 : 12; have = true; }
                if (have) {
                    pg8::EpiInT<true> E2{(pg8::bf16_t*)(F.ws + WS_Z), (const float*)(F.ws + WS_SSQB), (const float*)(F.ws + WS_BIN) + (size_t)l * NSEG * NZ, (const float*)(F.ws + WS_ROPE), 0};
                    pg8::Gemm g2{(const pg8::bf16_t*)(F.ws + WS_XM), (const pg8::bf16_t*)(F.ws + WS_WIN) + (size_t)l * NZ * 1024, MTOT, NZ, 1024, 128};
                    pg8::OneUnit O1; O1.u.pm = 2 * u.pm + hm; O1.u.pn = u.pn;
                    int tid_ = F.tid; asm volatile("; half-tile unit: lane constants re-derived" : "+v"(tid_));
                    pg8::gemm_phase<pg8::EpiInT<true>, pg8::OneUnit, true, true, true>(F.lds, g2, O1, E2, tid_);
                }
            }
        }
    } else if constexpr (PT == 4) phase_mixer(F, l, last);
    else if constexpr (PT == 3) phase_gla_finish(F, l, last);
    else if constexpr (PT == 5) {
        pg8::Gemm g{(const pg8::bf16_t*)(F.ws + WS_Y), (const pg8::bf16_t*)(F.ws + WS_WOUT) + (size_t)l * 1024 * 1024, MLAT, 1024, 1024, 256};
        pg8::StaticOrder S; S.init(MLAT, 1024, F.G, F.bx);
        pg8::bf16_t* XB = (pg8::bf16_t*)KOUT();
        if (l == 0) {
            pg8::EpiResT<true> E;
            E.xin_lat = KIN(I_X); E.xin_ctx = KIN(I_CTX); E.xbin = nullptr; E.xbout = XB;
            E.gt = modl + 2048; E.gn = KIN(I_N2G) + l * 1024; E.scn = modl + 4096;
            E.XM = (pg8::bf16_t*)(F.ws + WS_XM); E.ssq = (float*)(F.ws + WS_SSQA); E.row_base = 0;
            pg8::gemm_phase<pg8::EpiResT<true>, pg8::StaticOrder, true, true>(F.lds, g, S, E, F.tid);
            if (F.bx < 128) {
                pg8::EpiResT<true, true, true> E2;
                E2.xin_lat = KIN(I_X); E2.xin_ctx = KIN(I_CTX); E2.xbin = nullptr; E2.xbout = XB;
                E2.gt = modl + 2048; E2.gn = KIN(I_N2G) + l * 1024; E2.scn = modl + 4096;
                E2.XM = (pg8::bf16_t*)(F.ws + WS_XM); E2.ssq = (float*)(F.ws + WS_SSQA); E2.row_base = 0;
                pg8::Gemm g2{(const pg8::bf16_t*)(F.ws + WS_Y), (const pg8::bf16_t*)(F.ws + WS_WOUT) + (size_t)l * 1024 * 1024, MTOT, 1024, 1024, 128, 128};
                pg8::OneUnit O1; const int e = F.bx >> 2; O1.u.pm = 2 * (MLAT / 256 + (e >> 2)) + ((F.bx >> 1) & 1); O1.u.pn = 2 * (e & 3) + (F.bx & 1);
                int tid_ = F.tid; asm volatile("; quarter-tile unit: lane constants re-derived" : "+v"(tid_));
                pg8::gemm_phase<pg8::EpiResT<true, true, true>, pg8::OneUnit, true, true, true, true>(F.lds, g2, O1, E2, tid_);
            }
        } else {
            pg8::EpiResT<false> E;
            E.xin_lat = nullptr; E.xin_ctx = nullptr; E.xbin = XB; E.xbout = XB;
            E.gt = modl + 2048; E.gn = KIN(I_N2G) + l * 1024; E.scn = modl + 4096;
            E.XM = (pg8::bf16_t*)(F.ws + WS_XM); E.ssq = (float*)(F.ws + WS_SSQA); E.row_base = 0;
            pg8::gemm_phase<pg8::EpiResT<false>, pg8::StaticOrder, true, true>(F.lds, g, S, E, F.tid);
        }
        { float* zb = (float*)(F.ws + WS_SSQB); for (int i = F.vcu * NTHREADS + F.tid; i < MTOT; i += F.G * NTHREADS) zb[i] = 0.f; }
        if (l == 0 && F.bx >= 128) { convert_range(F, 0, CV_IN + CV_OUT, CV_ALL, (F.bx - 128) * NWAVES + F.wave, (F.G - 128) * NWAVES); bias_items(F, 46, 134, F.bx - 128, F.G - 128); }
    } else if constexpr (PT == 6) {
        const int mvalid = last ? MLAT : MTOT; const int ntile = (mvalid + 253) / 254;
        pg8::Gemm g{(const pg8::bf16_t*)(F.ws + WS_XM) - 1024, (const pg8::bf16_t*)(F.ws + WS_WUP) + (size_t)l * NUP * 1024, ntile * 256, NUP, 1024, 254};
        pg8::EpiUpConv E{(pg8::bf16_t*)(F.ws + WS_Z), (const float*)(F.ws + WS_SSQA), (const float*)(F.ws + WS_BUP) + (size_t)l * NSEG * NUP, KIN(I_CONVW) + (size_t)l * 3 * FFD, KIN(I_CONVB) + (size_t)l * FFD, mvalid, 0};
        pg8::OneUnit O1;
        if (F.tid < 17) { unsigned z_; asm volatile("v_mov_b32 %0, 0" : "=v"(z_)); *(LAS v4u*)(F.lds + 131248 + F.tid * 16) = (v4u){z_, z_, z_, z_}; }
        if (last) {
            pg8::StaticOrder S; S.init(ntile * 256, NUP, F.G, F.bx);
#pragma unroll 1
            for (int i = 0; S.next(i, O1.u); ++i) { int tid_ = F.tid; asm volatile("; per-unit re-derivation of the K-loop's lane constants" : "+v"(tid_)); pg8::gemm_phase<pg8::EpiUpConv, pg8::OneUnit, false, true>(F.lds, g, O1, E, tid_); }
        } else {
            constexpr int NFULL = 69, RB = 254 * NFULL, NHALF = (MTOT - RB + 125) / 126;
            pg8::UpOrderH S; S.init(NFULL, NUP / 256, NHALF, F.G, F.bx);
            pg8::EpiUpConvT<true> E2{(pg8::bf16_t*)(F.ws + WS_Z), (const float*)(F.ws + WS_SSQA), (const float*)(F.ws + WS_BUP) + (size_t)l * NSEG * NUP, KIN(I_CONVW) + (size_t)l * 3 * FFD, KIN(I_CONVB) + (size_t)l * FFD, mvalid, RB};
            pg8::Gemm g2{(const pg8::bf16_t*)(F.ws + WS_XM) + (size_t)(RB - 1) * 1024, (const pg8::bf16_t*)(F.ws + WS_WUP) + (size_t)l * NUP * 1024, MTOT, NUP, 1024, 126};
#pragma unroll 1
            for (int i = 0; S.next(i, O1.u); ++i) { int tid_ = F.tid; asm volatile("; per-unit re-derivation of the K-loop's lane constants" : "+v"(tid_));
                if (O1.u.pm < 1000) pg8::gemm_phase<pg8::EpiUpConv, pg8::OneUnit, false, true>(F.lds, g, O1, E, tid_);
                else { O1.u.pm -= 1000; pg8::gemm_phase<pg8::EpiUpConvT<true>, pg8::OneUnit, false, true, true>(F.lds, g2, O1, E2, tid_); } }
        }
    } else if constexpr (PT == 8) {
        pg8::Gemm g{(const pg8::bf16_t*)(F.ws + WS_Z), (const pg8::bf16_t*)(F.ws + WS_WDN) + (size_t)l * 1024 * FFD, MLAT, 1024, FFD, 256};
        pg8::StaticOrder S; S.init(MLAT, 1024, F.G, F.bx);
        pg8::EpiResT<false> E;
        E.xin_lat = nullptr; E.xin_ctx = nullptr; E.xbin = (const pg8::bf16_t*)KOUT(); E.xbout = last ? (pg8::bf16_t*)(F.ws + WS_XM) : (pg8::bf16_t*)KOUT();
        E.gt = modl + 5120;
        if (!last) { E.gn = KIN(I_N1G) + (l + 1) * 1024; E.scn = modl + NSEG * MODW + 1024; } else { E.gn = nullptr; E.scn = nullptr; }
        E.XM = (pg8::bf16_t*)(F.ws + WS_XM); E.ssq = (float*)(F.ws + WS_SSQB); E.row_base = 0;
        pg8::gemm_phase<pg8::EpiResT<false>, pg8::StaticOrder, true, true>(F.lds, g, S, E, F.tid);
        if (!last && F.bx < 128) {
            pg8::EpiResT<false, true, true> E2;
            E2.xin_lat = nullptr; E2.xin_ctx = nullptr; E2.xbin = (const pg8::bf16_t*)KOUT(); E2.xbout = (pg8::bf16_t*)KOUT();
            E2.gt = modl + 5120; E2.gn = KIN(I_N1G) + (l + 1) * 1024; E2.scn = modl + NSEG * MODW + 1024;
            E2.XM = (pg8::bf16_t*)(F.ws + WS_XM); E2.ssq = (float*)(F.ws + WS_SSQB); E2.row_base = 0;
            pg8::Gemm g2{(const pg8::bf16_t*)(F.ws + WS_Z), (const pg8::bf16_t*)(F.ws + WS_WDN) + (size_t)l * 1024 * FFD, MTOT, 1024, FFD, 128, 128};
            pg8::OneUnit O1; const int e = F.bx >> 2; O1.u.pm = 2 * (MLAT / 256 + (e >> 2)) + ((F.bx >> 1) & 1); O1.u.pn = 2 * (e & 3) + (F.bx & 1);
            int tid_ = F.tid; asm volatile("; quarter-tile unit: lane constants re-derived" : "+v"(tid_));
            pg8::gemm_phase<pg8::EpiResT<false, true, true>, pg8::OneUnit, true, true, true, true>(F.lds, g2, O1, E2, tid_);
        }
        { float* za = (float*)(F.ws + WS_SSQA); for (int i = F.vcu * NTHREADS + F.tid; i < MTOT; i += F.G * NTHREADS) za[i] = 0.f; }
        if (l == 0 && F.bx >= 128) { convert_range(F, 1, 0, CV_ALL, (F.bx - 128) * NWAVES + F.wave, (F.G - 128) * NWAVES); gate_fold(F, 1, (F.bx - 128) * NTHREADS + F.tid, (F.G - 128) * NTHREADS); bias_items(F, 134, 268, F.bx - 128, F.G - 128); }
    } else phase_final(F);
}
__global__ void __launch_bounds__(NTHREADS, 2) mk_fwd(Args args) {
    extern __shared__ __attribute__((aligned(16))) unsigned char lds_raw[];
    LAS unsigned char* lds0 = (LAS unsigned char*)lds_raw;
    volatile LAS unsigned* MISC = (volatile LAS unsigned*)(lds0 + MISC_OFF);
    for (int u = threadIdx.x; u < (LDS_BYTES - MISC_OFF) / 4; u += NTHREADS) ((LAS unsigned*)(lds0 + MISC_OFF))[u] = 0u;
    __syncthreads();
    const int wave_id = __builtin_amdgcn_readfirstlane(threadIdx.x >> 6);
    XcdBarrier bar = xcd_barrier_post((unsigned*)(args.ws + WS_CTL) + CW_BAR, MISC + 8);
    run_phase<0>(wave_id, lds0, 0); xcd_barrier(bar, wave_id);
    run_phase<1>(wave_id, lds0, 0); xcd_barrier(bar, wave_id);
#pragma unroll 1
    for (int l = 0; l < DEPTH; ++l) {
        run_phase<2>(wave_id, lds0, l); xcd_barrier(bar, wave_id);
        run_phase<4>(wave_id, lds0, l); xcd_barrier(bar, wave_id);
        run_phase<3>(wave_id, lds0, l); xcd_barrier(bar, wave_id);
        run_phase<5>(wave_id, lds0, l); xcd_barrier(bar, wave_id);
        run_phase<6>(wave_id, lds0, l); xcd_barrier(bar, wave_id);
        run_phase<8>(wave_id, lds0, l); xcd_barrier(bar, wave_id);
    }
    run_phase<9>(wave_id, lds0, 0);
}

extern "C" void kernel_launch(void* const* d_in, const int* in_sizes, int n_in, void* d_out, int out_size, void* d_ws, size_t ws_size, hipStream_t stream) {
    static int grid = 0;
    if (grid == 0) {
        if (n_in != 20 || out_size != MLAT * 1024 || ws_size < WS_END) { fprintf(stderr, "kernel_launch: unexpected shapes (n_in %d out %d ws %zu); nothing launched\n", n_in, out_size, ws_size); grid = -1; return; }
        int dev = 0, cus = 0;
        if (hipGetDevice(&dev) != hipSuccess || hipDeviceGetAttribute(&cus, hipDeviceAttributeMultiprocessorCount, dev) != hipSuccess) { grid = -1; return; }
        if (hipFuncSetAttribute((const void*)mk_fwd, hipFuncAttributeMaxDynamicSharedMemorySize, LDS_BYTES) != hipSuccess) { fprintf(stderr, "kernel_launch: hipFuncSetAttribute failed\n"); grid = -1; return; }
        (void)hipGetLastError();
        grid = cus;
    }
    if (grid < 0) return;
    (void)hipMemsetAsync((char*)d_ws + WS_CTL, 0, CTL_ZERO_BYTES, stream);
    Args a{};
    for (int i = 0; i < 20; ++i) a.in[i] = (const float*)d_in[i];
    a.out = (float*)d_out; a.ws = (unsigned char*)d_ws;
    hipLaunchKernelGGL(mk_fwd, dim3(grid), dim3(NTHREADS), LDS_BYTES, stream, a);
}
```

```cpp
#include <hip/hip_runtime.h>
#include <cstdio>
#include <cstdint>
__device__ __forceinline__ float lxor(float v, int lane, int X) { return __builtin_bit_cast(float, __builtin_amdgcn_ds_bpermute((lane ^ X) << 2, __builtin_bit_cast(int, v))); }
__device__ __forceinline__ float xmax_16_32(float v) {
    unsigned a = __builtin_bit_cast(unsigned, v), b = a;
    asm("s_nop 1\n\tv_permlane16_swap_b32 %0, %1\n\ts_nop 1" : "+v"(a), "+v"(b));
    const float m = fmaxf(__builtin_bit_cast(float, a), __builtin_bit_cast(float, b));
    a = __builtin_bit_cast(unsigned, m); b = a;
    asm("s_nop 1\n\tv_permlane32_swap_b32 %0, %1\n\ts_nop 1" : "+v"(a), "+v"(b));
    return fmaxf(__builtin_bit_cast(float, a), __builtin_bit_cast(float, b));
}
__device__ __forceinline__ float xsum_16_32(float v) {
    unsigned a = __builtin_bit_cast(unsigned, v), b = a;
    asm("s_nop 1\n\tv_permlane16_swap_b32 %0, %1\n\ts_nop 1" : "+v"(a), "+v"(b));
    const float m = __builtin_bit_cast(float, a) + __builtin_bit_cast(float, b);
    a = __builtin_bit_cast(unsigned, m); b = a;
    asm("s_nop 1\n\tv_permlane32_swap_b32 %0, %1\n\ts_nop 1" : "+v"(a), "+v"(b));
    return __builtin_bit_cast(float, a) + __builtin_bit_cast(float, b);
}
namespace pg8 {
#define PG8_LAS __attribute__((address_space(3)))
typedef unsigned short bf16_t;
typedef short bf16x8 __attribute__((ext_vector_type(8)));
typedef float f32x4 __attribute__((ext_vector_type(4)));
typedef unsigned u32x4 __attribute__((ext_vector_type(4)));
constexpr int BM = 256, BK = 64, HALF = 128, HTB = HALF * BK * 2  , STAGE_BYTES = 8 * HTB, NXCD = 8, WGM = 8;

__host__ __device__ __forceinline__ int lds_byte(int r, int c) { const int st = (r >> 4) * 2 + (c >> 5), rr = r & 15, cc = c & 31, ob = rr * 64 + cc * 2; return st * 1024 + (ob ^ (((ob >> 9) & 1) << 5)); }
__host__ __device__ __forceinline__ void stage_rc(int b, int& R, int& C) { const int st = b / 1024, sb = b % 1024, swz = sb ^ (((sb >> 9) & 1) << 5); R = (st >> 1) * 16 + swz / 64; C = (st & 1) * 32 + (swz % 64) / 2; }
__host__ __device__ __forceinline__ int perm32(int rho) { const int n = rho >> 4, i = rho & 15; return 8 * (i >> 2) + 4 * n + (i & 3); }

struct Unit { int pm, pn; };
struct Gemm { const bf16_t* A; const bf16_t* Bt; int M, N, K, Mstep, Nstep; };

struct StaticOrder {
    int nM, nN, nwg, G, c;
    __host__ __device__ void init(int M, int N, int G_, int c_) { nM = M / BM; nN = N / BM; nwg = nM * nN; G = G_; c = c_; }
    __host__ __device__ bool next(int i, Unit& u) const {
        const long L = (long)i * G + c; if (L >= nwg) return false;
        int wgid = (int)L; { const int q = nwg / NXCD, r = nwg % NXCD, xcd = wgid % NXCD, off = wgid / NXCD; wgid = (xcd < r ? xcd * (q + 1) : r * (q + 1) + (xcd - r) * q) + off; }
        const int nig = WGM * nN, gid = wgid / nig, fm = gid * WGM, gsz = (nM - fm) < WGM ? (nM - fm) : WGM;
        u.pm = fm + ((wgid % nig) % gsz); u.pn = (wgid % nig) / gsz; return true;
    }
    __device__ __forceinline__ void a_ready(const Unit&) const {}
    __device__ __forceinline__ void done(const Unit&) const {}
};

struct UpOrderH {
    StaticOrder a; int nA, nN, nTot, G, c;
    __host__ __device__ void init(int nMA, int nN_, int nHalfRows, int G_, int c_) { nN = nN_; nA = nMA * nN; nTot = nA + nHalfRows * nN; G = G_; c = c_; a.nM = nMA; a.nN = nN; a.nwg = nA; a.G = G_; a.c = c_; }
    __host__ __device__ bool next(int i, Unit& u) const {
        const int L = i * G + c; if (L >= nTot) return false;
        if (L < nA) return a.next(i, u);
        const int r = L - nA; u.pm = 1000 + r / nN; u.pn = r % nN; return true;
    }
};
__device__ __forceinline__ unsigned cvt_pk_bf16(float lo, float hi) { unsigned r; asm volatile("v_cvt_pk_bf16_f32 %0, %1, %2" : "=v"(r) : "v"(lo), "v"(hi)); return r; }
typedef float f32x2 __attribute__((ext_vector_type(2)));
__device__ __forceinline__ f32x2 gelu_pk(f32x2 v) {
    const f32x2 av = __builtin_elementwise_abs(v), d = av * 0.2316418882f + 1.0f;
    f32x2 t; t.x = __builtin_amdgcn_rcpf(d.x); t.y = __builtin_amdgcn_rcpf(d.y);
    f32x2 q = t * 0.5307027145f + (-0.7265760135f); q = q * t + 0.7107068705f; q = q * t + (-0.142248368f); q = q * t + 0.127414796f; q = q * t;
    const f32x2 s = (v * v) * (-0.72134752044f);
    f32x2 e; e.x = __builtin_amdgcn_exp2f(s.x); e.y = __builtin_amdgcn_exp2f(s.y);
    const f32x2 m = av * (q * e);
    f32x2 r; r.x = fmaxf(v.x, 0.f); r.y = fmaxf(v.y, 0.f); return r - m;
}
__device__ __forceinline__ void gelu_pk2(f32x2 va, f32x2 vb, f32x2& oa, f32x2& ob) {
    const f32x2 aa = __builtin_elementwise_abs(va), ab = __builtin_elementwise_abs(vb);
    const f32x2 da = aa * 0.2316418882f + 1.0f, db = ab * 0.2316418882f + 1.0f;
    f32x2 ta, tb; ta.x = __builtin_amdgcn_rcpf(da.x); ta.y = __builtin_amdgcn_rcpf(da.y); tb.x = __builtin_amdgcn_rcpf(db.x); tb.y = __builtin_amdgcn_rcpf(db.y);
    const f32x2 sa = (va * va) * (-0.72134752044f), sb = (vb * vb) * (-0.72134752044f);
    f32x2 ea, eb; ea.x = __builtin_amdgcn_exp2f(sa.x); ea.y = __builtin_amdgcn_exp2f(sa.y); eb.x = __builtin_amdgcn_exp2f(sb.x); eb.y = __builtin_amdgcn_exp2f(sb.y);
    f32x2 qa = ta * 0.5307027145f + (-0.7265760135f), qb = tb * 0.5307027145f + (-0.7265760135f);
    qa = qa * ta + 0.7107068705f; qb = qb * tb + 0.7107068705f;
    qa = qa * ta + (-0.142248368f); qb = qb * tb + (-0.142248368f);
    qa = qa * ta + 0.127414796f; qb = qb * tb + 0.127414796f;
    qa = qa * ta; qb = qb * tb;
    const f32x2 pa = qa * ea, pb = qb * eb;
    f32x2 ra, rb; ra.x = fmaxf(va.x, 0.f); ra.y = fmaxf(va.y, 0.f); rb.x = fmaxf(vb.x, 0.f); rb.y = fmaxf(vb.y, 0.f);
    oa = ra - aa * pa; ob = rb - ab * pb;
}
typedef unsigned u32x2 __attribute__((ext_vector_type(2)));
constexpr int MLAT = 16384, MCTX = 2048, MTOT = 18432, DMODEL = 1024, NZ = 3328, NUP = 5632, FFD = 2816, MODW = 6144;
__device__ __forceinline__ int seg_of(int grow) { return grow < MLAT ? (grow >> 11) : 8; }
__device__ __forceinline__ float row_rinv(const float* ssq, int grow) { return 1.0f / sqrtf(ssq[grow] * (1.0f / 1024.0f) + 1e-6f); }
__device__ __forceinline__ float logsig16(float x) {
    const float t = __builtin_amdgcn_exp2f(-fabsf(x) * 1.4426950408889634f); return (fminf(x, 0.f) - __builtin_amdgcn_logf(1.0f + t) * 0.6931471805599453f) * (1.0f / 16.0f); }

template <bool HM> struct EpiInT {
    static constexpr bool PERM = true, AFTER_DRAIN = false;
    bf16_t* Z; const float* ssq; const float* bias; const float* cosT; int row_base;
    __device__ __forceinline__ void operator()(const f32x4 (&acc)[2][2][4][2], const Unit& u, int wr, int wc, int fr, int fq) const {
        asm volatile("; epilogue: per-lane indices re-derived here, not hoisted above the K-loop" : "+v"(fr), "+v"(fq));
        const int grow0 = row_base + u.pm * (HM ? HALF : BM), seg = seg_of(grow0);
        const int col0 = u.pn * BM + wc * 32 + 8 * fq;
        const float* bs = bias + (size_t)seg * NZ;
        const bool gate = u.pn >= 11;
        const bool lat = grow0 < MLAT;
        const int a4 = 4 * (4 * (wc & 1) + fq);
        float riv[2][4];
#pragma unroll
        for (int ai = 0; ai < (HM ? 1 : 2); ++ai)
#pragma unroll
            for (int m = 0; m < 4; ++m) riv[ai][m] = ssq[grow0 + ai * HALF + wr * 64 + m * 16 + fr];
#pragma unroll
        for (int ai = 0; ai < (HM ? 1 : 2); ++ai)
#pragma unroll
            for (int m = 0; m < 4; ++m) riv[ai][m] = 1.0f / sqrtf(riv[ai][m] * (1.0f / 1024.0f) + 1e-6f);
#pragma unroll
        for (int bj = 0; bj < 2; ++bj) {
            const bool rot = (u.pn == 3) || (u.pn == 4 && bj == 0);
            const int hb = u.pn * BM + bj * HALF + (wc >> 1) * 64;
            const int cA = rot ? hb + a4 : col0 + bj * HALF, cB = rot ? hb + 32 + a4 : col0 + bj * HALF + 4;
            const f32x4 b0 = *(const f32x4*)(bs + cA), b1 = *(const f32x4*)(bs + cB);
#pragma unroll
            for (int ai = 0; ai < (HM ? 1 : 2); ++ai)
#pragma unroll
                for (int m = 0; m < 4; ++m) {
                    const int grow = grow0 + ai * HALF + wr * 64 + m * 16 + fr;
                    const float ri = riv[ai][m];
                    f32x4 v0 = acc[ai][bj][m][0] * ri + b0, v1 = acc[ai][bj][m][1] * ri + b1;
                    if (gate) {
#pragma unroll
                        for (int j = 0; j < 4; ++j) { v0[j] = logsig16(v0[j]); v1[j] = logsig16(v1[j]); }
                    }
                    if (rot && lat) { const int t = grow & 2047; const f32x4 cs = *(const f32x4*)(cosT + t * 32 + a4), sn = *(const f32x4*)(cosT + 2048 * 32 + t * 32 + a4);
                        const f32x4 o1 = v0 * cs - v1 * sn, o2 = v0 * sn + v1 * cs; v0 = o1; v1 = o2; }
                    u32x2 w0, w1; w0.x = cvt_pk_bf16(v0[0], v0[1]); w0.y = cvt_pk_bf16(v0[2], v0[3]); w1.x = cvt_pk_bf16(v1[0], v1[1]); w1.y = cvt_pk_bf16(v1[2], v1[3]);
                    if (rot) { *(u32x2*)(Z + (size_t)grow * NZ + cA) = w0; *(u32x2*)(Z + (size_t)grow * NZ + cB) = w1; }
                    else *(u32x4*)(Z + (size_t)grow * NZ + cA) = (u32x4){w0.x, w0.y, w1.x, w1.y};
                }
        }
    }
};
using EpiIn = EpiInT<false>;
template <bool HM> struct EpiUpConvT {
    static constexpr bool PERM = true, AFTER_DRAIN = true;
    bf16_t* H; const float* ssq; const float* bias; const float* cw; const float* cb; int mvalid; int rbase;
    __device__ __forceinline__ void fused(f32x4 (&a)[2][2][4][2], const Unit& u, int wr, int wc, int fr, int fq, PG8_LAS unsigned char* lds, int wid, int lane) const {
        PG8_LAS float* rinvL = (PG8_LAS float*)lds; PG8_LAS int* segL = (PG8_LAS int*)(lds + 1024); PG8_LAS unsigned char* gt = lds + 2048;
        constexpr int NR = HM ? 128 : 256;
        const int row0 = HM ? rbase + u.pm * 126 - 1 : u.pm * 254 - 1;
        const int f0 = u.pn * 128 + wc * 32 + 8 * fq;
        { const int t = wid * 64 + lane; if (t < NR) { const int grow = row0 + t; const int gc = grow < 0 ? 0 : (grow > MTOT - 1 ? MTOT - 1 : grow); rinvL[t] = row_rinv(ssq, gc); segL[t] = seg_of(gc); } }
        asm volatile("s_waitcnt vmcnt(0) lgkmcnt(0)" ::: "memory"); __builtin_amdgcn_s_barrier(); asm volatile("" ::: "memory");
        const int segA = segL[0], segB = segL[NR - 1];
        f32x4 bvA[2][2], bvB[2][2];
#pragma unroll
        for (int n = 0; n < 2; ++n) { bvA[0][n] = *(const f32x4*)(bias + (size_t)segA * NUP + f0 + 4 * n); bvA[1][n] = *(const f32x4*)(bias + (size_t)segA * NUP + FFD + f0 + 4 * n);
            bvB[0][n] = *(const f32x4*)(bias + (size_t)segB * NUP + f0 + 4 * n); bvB[1][n] = *(const f32x4*)(bias + (size_t)segB * NUP + FFD + f0 + 4 * n); }
#pragma unroll
        for (int ai = 0; ai < (HM ? 1 : 2); ++ai)
#pragma unroll
            for (int m = 0; m < 4; ++m) {
                const int lrow = ai * HALF + wr * 64 + m * 16 + fr;
                const float ri = rinvL[lrow];
                const bool isA = segL[lrow] == segA;
#pragma unroll
                for (int n = 0; n < 2; ++n) { a[ai][0][m][n] = a[ai][0][m][n] * ri + (isA ? bvA[0][n] : bvB[0][n]); a[ai][1][m][n] = a[ai][1][m][n] * ri + (isA ? bvA[1][n] : bvB[1][n]); }
                u32x4 w; w.x = cvt_pk_bf16(a[ai][1][m][0][0], a[ai][1][m][0][1]); w.y = cvt_pk_bf16(a[ai][1][m][0][2], a[ai][1][m][0][3]); w.z = cvt_pk_bf16(a[ai][1][m][1][0], a[ai][1][m][1][1]); w.w = cvt_pk_bf16(a[ai][1][m][1][2], a[ai][1][m][1][3]);
                *(PG8_LAS u32x4*)(gt + lrow * 272 + (wc * 32 + 8 * fq) * 2) = w;
            }
        asm volatile("s_waitcnt lgkmcnt(0)" ::: "memory"); __builtin_amdgcn_s_barrier(); asm volatile("" ::: "memory");
        unsigned keep[2][4][2];
#pragma unroll
        for (int n = 0; n < 2; ++n) {
            const f32x4 w0 = *(const f32x4*)(cw + f0 + 4 * n), w1 = *(const f32x4*)(cw + FFD + f0 + 4 * n), w2 = *(const f32x4*)(cw + 2 * FFD + f0 + 4 * n), cbv = *(const f32x4*)(cb + f0 + 4 * n);
#pragma unroll
            for (int ai = 0; ai < (HM ? 1 : 2); ++ai)
#pragma unroll
                for (int m = 0; m < 4; ++m) {
                    const int lrow = ai * HALF + wr * 64 + m * 16 + fr, grow = row0 + lrow;
                    int pos, len; if (grow < MLAT) { pos = grow & 2047; len = 2048; } else { pos = (grow - MLAT) & 255; len = 256; }
                    const bool hasup = (lrow > 0) && (pos > 0), hasdn = (lrow < NR - 1) && (pos < len - 1);
                    const int rup = hasup ? lrow - 1 : 475, rdn = hasdn ? lrow + 1 : 475;
                    const u32x2 gu = *(const PG8_LAS u32x2*)(gt + rup * 272 + (wc * 32 + 8 * fq + 4 * n) * 2), gd = *(const PG8_LAS u32x2*)(gt + rdn * 272 + (wc * 32 + 8 * fq + 4 * n) * 2);
                    const unsigned guw[2] = {gu.x, gu.y}, gdw[2] = {gd.x, gd.y};
                    unsigned ow[2];
                    f32x2 x2[2];
#pragma unroll
                    for (int q = 0; q < 2; ++q) {
                        const f32x2 u2 = {__builtin_bit_cast(float, guw[q] << 16), __builtin_bit_cast(float, guw[q] & 0xffff0000u)};
                        const f32x2 d2 = {__builtin_bit_cast(float, gdw[q] << 16), __builtin_bit_cast(float, gdw[q] & 0xffff0000u)};
                        const f32x2 own2 = {a[ai][1][m][n][2 * q], a[ai][1][m][n][2 * q + 1]};
                        const f32x2 w0p = {w0[2 * q], w0[2 * q + 1]}, w1p = {w1[2 * q], w1[2 * q + 1]}, w2p = {w2[2 * q], w2[2 * q + 1]}, cbp = {cbv[2 * q], cbv[2 * q + 1]};
                        f32x2 t2 = w0p * u2 + cbp; t2 = w1p * own2 + t2; x2[q] = w2p * d2 + t2;
                    }
                    f32x2 g0, g1; gelu_pk2(x2[0], x2[1], g0, g1);
                    { const f32x2 v0 = {a[ai][0][m][n][0], a[ai][0][m][n][1]}, v1 = {a[ai][0][m][n][2], a[ai][0][m][n][3]}; const f32x2 o0 = g0 * v0, o1 = g1 * v1; ow[0] = cvt_pk_bf16(o0.x, o0.y); ow[1] = cvt_pk_bf16(o1.x, o1.y); }
                    if (n == 0) { keep[ai][m][0] = ow[0]; keep[ai][m][1] = ow[1]; }
                    else if (lrow >= 1 && lrow <= NR - 2 && grow < mvalid) *(u32x4*)(H + (size_t)grow * FFD + f0) = (u32x4){keep[ai][m][0], keep[ai][m][1], ow[0], ow[1]};
                    asm volatile("" ::: "memory");
                }
        }
        asm volatile("s_waitcnt lgkmcnt(0)" ::: "memory"); __builtin_amdgcn_s_barrier(); asm volatile("" ::: "memory");
    }
};
using EpiUpConv = EpiUpConvT<false>;
struct OneUnit {
    Unit u;
    __device__ __forceinline__ bool next(int i, Unit& o) const { if (i != 0) return false; o = u; return true; }
    __device__ __forceinline__ void a_ready(const Unit&) const {}
    __device__ __forceinline__ void done(const Unit&) const {}
};
template <bool INF32, bool HM = false, bool HN = false> struct EpiResT {
    static constexpr bool PERM = true, AFTER_DRAIN = false;
    const float* xin_lat; const float* xin_ctx; const bf16_t* xbin; bf16_t* xbout;
    const float* gt; const float* gn; const float* scn; bf16_t* XM; float* ssq; int row_base;
    __device__ __forceinline__ void operator()(const f32x4 (&acc)[2][2][4][2], const Unit& u, int wr, int wc, int fr, int fq) const {
        asm volatile("; epilogue: per-lane indices re-derived here, not hoisted above the K-loop" : "+v"(fr), "+v"(fq));
        const int grow0 = row_base + u.pm * (HM ? HALF : BM), seg = seg_of(grow0);
        const bool lat = grow0 < MLAT;
        const float* xin = INF32 ? (lat ? xin_lat + (size_t)grow0 * DMODEL : xin_ctx + (size_t)(grow0 - MLAT) * DMODEL) : nullptr;
        const bf16_t* xbi = INF32 ? nullptr : xbin + (size_t)grow0 * DMODEL;
        bf16_t* xbo = xbout + (size_t)grow0 * DMODEL;
        const int col0 = u.pn * (HN ? HALF : BM) + wc * 32 + 8 * fq;
        float ss[2][4];
#pragma unroll
        for (int ai = 0; ai < 2; ++ai)
#pragma unroll
            for (int m = 0; m < 4; ++m) ss[ai][m] = 0.f;
        f32x4 xa[2][2], xb[2][2];
        bf16_t* xmb = XM + (size_t)grow0 * DMODEL;
#define ER_LOAD(dst, bj_, ai_, mp_) do { _Pragma("unroll") for (int mm = 0; mm < 2; ++mm) { const unsigned off = (unsigned)(((ai_) * HALF + wr * 64 + (2 * (mp_) + mm) * 16 + fr) * DMODEL + col0 + (bj_) * HALF); \
        if constexpr (INF32) { dst[mm][0] = *(const f32x4*)(xin + off); dst[mm][1] = *(const f32x4*)(xin + off + 4); } \
        else { const u32x4 q_ = *(const u32x4*)(xbi + off); dst[mm][0] = __builtin_bit_cast(f32x4, q_); } } } while (0)
#define ER_DO(src, bj_, ai_, mp_) do { const int c = col0 + (bj_) * HALF; \
        _Pragma("unroll") for (int mm = 0; mm < 2; ++mm) { const int m = 2 * (mp_) + mm; const int lrow = (ai_) * HALF + wr * 64 + m * 16 + fr; const unsigned off = (unsigned)(lrow * DMODEL + c); \
            f32x4 xo0, xo1; \
            if constexpr (INF32) { xo0 = src[mm][0]; xo1 = src[mm][1]; } \
            else { const u32x4 q_ = __builtin_bit_cast(u32x4, src[mm][0]); \
                xo0 = (f32x4){__builtin_bit_cast(float, q_.x << 16), __builtin_bit_cast(float, q_.x & 0xffff0000u), __builtin_bit_cast(float, q_.y << 16), __builtin_bit_cast(float, q_.y & 0xffff0000u)}; \
                xo1 = (f32x4){__builtin_bit_cast(float, q_.z << 16), __builtin_bit_cast(float, q_.z & 0xffff0000u), __builtin_bit_cast(float, q_.w << 16), __builtin_bit_cast(float, q_.w & 0xffff0000u)}; } \
            const f32x4 xn0 = xo0 + gtv[bj_][0] * acc[ai_][bj_][m][0], xn1 = xo1 + gtv[bj_][1] * acc[ai_][bj_][m][1]; \
            { u32x4 w; w.x = cvt_pk_bf16(xn0[0], xn0[1]); w.y = cvt_pk_bf16(xn0[2], xn0[3]); w.z = cvt_pk_bf16(xn1[0], xn1[1]); w.w = cvt_pk_bf16(xn1[2], xn1[3]); *(u32x4*)(xbo + off) = w; } \
            ss[ai_][m] += ((xn0[0] * xn0[0] + xn0[1] * xn0[1]) + (xn0[2] * xn0[2] + xn0[3] * xn0[3])) + ((xn1[0] * xn1[0] + xn1[1] * xn1[1]) + (xn1[2] * xn1[2] + xn1[3] * xn1[3])); \
            if (gn) { const f32x4 xm0 = xn0 * gmv[bj_][0], xm1 = xn1 * gmv[bj_][1]; u32x4 w; w.x = cvt_pk_bf16(xm0[0], xm0[1]); w.y = cvt_pk_bf16(xm0[2], xm0[3]); w.z = cvt_pk_bf16(xm1[0], xm1[1]); w.w = cvt_pk_bf16(xm1[2], xm1[3]); \
                *(u32x4*)(xmb + off) = w; } } } while (0)
        f32x4 gtv[2][2], gmv[2][2];
#define ER_MODV(bj_) do { _Pragma("unroll") for (int n = 0; n < 2; ++n) { const int c = col0 + (bj_) * HALF + 4 * n; gtv[bj_][n] = *(const f32x4*)(gt + (size_t)seg * MODW + c); \
        gmv[bj_][n] = gn ? *(const f32x4*)(gn + c) * (*(const f32x4*)(scn + (size_t)seg * MODW + c) + 1.0f) : (f32x4){0.f, 0.f, 0.f, 0.f}; } } while (0)
        ER_MODV(0);
        ER_LOAD(xa, 0, 0, 0);
#define ER_STEP(cur, nxt, bj_, ai_, mp_, nbj_, nai_, nmp_) do { ER_LOAD(nxt, nbj_, nai_, nmp_); asm volatile("" ::: "memory"); ER_DO(cur, bj_, ai_, mp_); asm volatile("" ::: "memory"); } while (0)
        if constexpr (HM && HN) {
            ER_STEP(xa, xb, 0, 0, 0, 0, 0, 1);
            ER_DO(xb, 0, 0, 1);
        } else if constexpr (HM) {
            ER_STEP(xa, xb, 0, 0, 0, 0, 0, 1);
            ER_MODV(1);
            ER_STEP(xb, xa, 0, 0, 1, 1, 0, 0);
            ER_STEP(xa, xb, 1, 0, 0, 1, 0, 1);
            ER_DO(xb, 1, 0, 1);
        } else {
        ER_STEP(xa, xb, 0, 0, 0, 0, 0, 1);
        ER_STEP(xb, xa, 0, 0, 1, 0, 1, 0);
        ER_STEP(xa, xb, 0, 1, 0, 0, 1, 1);
        ER_MODV(1);
        ER_STEP(xb, xa, 0, 1, 1, 1, 0, 0);
        ER_STEP(xa, xb, 1, 0, 0, 1, 0, 1);
        ER_STEP(xb, xa, 1, 0, 1, 1, 1, 0);
        ER_STEP(xa, xb, 1, 1, 0, 1, 1, 1);
        ER_DO(xb, 1, 1, 1);
        }
#undef ER_STEP
#undef ER_MODV
#undef ER_LOAD
#undef ER_DO
#pragma unroll
        for (int ai = 0; ai < (HM ? 1 : 2); ++ai)
#pragma unroll
            for (int m = 0; m < 4; ++m) {
                const int lrow = ai * HALF + wr * 64 + m * 16 + fr;
                const float s = xsum_16_32(ss[ai][m]);
                if (fq == 0) __hip_atomic_fetch_add(ssq + (grow0 + lrow), s, __ATOMIC_RELAXED, __HIP_MEMORY_SCOPE_AGENT);
            }
    }
};

struct EpiFinal {
    static constexpr bool PERM = true, AFTER_DRAIN = false;
    const bf16_t* xbin; const float* gt; const float* fg; float* out; float* ssq; unsigned* cnt;
    __device__ __forceinline__ void operator()(const f32x4 (&acc_)[2][2][4][2], const Unit& u, int wr, int wc, int fr, int fq) const {
        asm volatile("; epilogue: per-lane indices re-derived here, not hoisted above the K-loop" : "+v"(fr), "+v"(fq));
        f32x4 (&acc)[2][2][4][2] = const_cast<f32x4 (&)[2][2][4][2]>(acc_);
        const int grow0 = u.pm * BM, seg = seg_of(grow0);
        const bf16_t* xbi = xbin + (size_t)grow0 * DMODEL;
        const int col0 = u.pn * BM + wc * 32 + 8 * fq;
        float ss[2][4];
#pragma unroll
        for (int ai = 0; ai < 2; ++ai)
#pragma unroll
            for (int m = 0; m < 4; ++m) ss[ai][m] = 0.f;
        u32x4 xa[2], xb[2];
#define EF_LOAD(dst, bj_, ai_, mp_) do { _Pragma("unroll") for (int mm = 0; mm < 2; ++mm) { const unsigned off = (unsigned)(((ai_) * HALF + wr * 64 + (2 * (mp_) + mm) * 16 + fr) * DMODEL + col0 + (bj_) * HALF); \
        dst[mm] = *(const u32x4*)(xbi + off); } } while (0)
#define EF_DO(src, bj_, ai_, mp_) do { \
        _Pragma("unroll") for (int mm = 0; mm < 2; ++mm) { const int m = 2 * (mp_) + mm; const u32x4 q_ = src[mm]; \
            const f32x4 xo0 = (f32x4){__builtin_bit_cast(float, q_.x << 16), __builtin_bit_cast(float, q_.x & 0xffff0000u), __builtin_bit_cast(float, q_.y << 16), __builtin_bit_cast(float, q_.y & 0xffff0000u)}; \
            const f32x4 xo1 = (f32x4){__builtin_bit_cast(float, q_.z << 16), __builtin_bit_cast(float, q_.z & 0xffff0000u), __builtin_bit_cast(float, q_.w << 16), __builtin_bit_cast(float, q_.w & 0xffff0000u)}; \
            const f32x4 xn0 = xo0 + gtv[bj_][0] * acc[ai_][bj_][m][0], xn1 = xo1 + gtv[bj_][1] * acc[ai_][bj_][m][1]; \
            acc[ai_][bj_][m][0] = xn0; acc[ai_][bj_][m][1] = xn1; \
            ss[ai_][m] += ((xn0[0] * xn0[0] + xn0[1] * xn0[1]) + (xn0[2] * xn0[2] + xn0[3] * xn0[3])) + ((xn1[0] * xn1[0] + xn1[1] * xn1[1]) + (xn1[2] * xn1[2] + xn1[3] * xn1[3])); } } while (0)
        f32x4 gtv[2][2];
#define EF_MODV(bj_) do { _Pragma("unroll") for (int n = 0; n < 2; ++n) { const int c = col0 + (bj_) * HALF + 4 * n; gtv[bj_][n] = *(const f32x4*)(gt + (size_t)seg * MODW + c); } } while (0)
        EF_MODV(0);
        EF_LOAD(xa, 0, 0, 0);
#define EF_STEP(cur, nxt, bj_, ai_, mp_, nbj_, nai_, nmp_) do { EF_LOAD(nxt, nbj_, nai_, nmp_); asm volatile("" ::: "memory"); EF_DO(cur, bj_, ai_, mp_); asm volatile("" ::: "memory"); } while (0)
        EF_STEP(xa, xb, 0, 0, 0, 0, 0, 1);
        EF_STEP(xb, xa, 0, 0, 1, 0, 1, 0);
        EF_STEP(xa, xb, 0, 1, 0, 0, 1, 1);
        EF_MODV(1);
        EF_STEP(xb, xa, 0, 1, 1, 1, 0, 0);
        EF_STEP(xa, xb, 1, 0, 0, 1, 0, 1);
        EF_STEP(xb, xa, 1, 0, 1, 1, 1, 0);
        EF_STEP(xa, xb, 1, 1, 0, 1, 1, 1);
        EF_DO(xb, 1, 1, 1);
#undef EF_STEP
#undef EF_MODV
#undef EF_LOAD
#undef EF_DO
#pragma unroll
        for (int ai = 0; ai < 2; ++ai)
#pragma unroll
            for (int m = 0; m < 4; ++m) {
                const int lrow = ai * HALF + wr * 64 + m * 16 + fr;
                const float s = xsum_16_32(ss[ai][m]);
                if (fq == 0) __hip_atomic_fetch_add(ssq + (grow0 + lrow), s, __ATOMIC_RELAXED, __HIP_MEMORY_SCOPE_AGENT);
            }
        asm volatile("s_waitcnt vmcnt(0)" ::: "memory"); __builtin_amdgcn_s_barrier(); asm volatile("" ::: "memory");
        if (wr == 0 && wc == 0 && fr == 0 && fq == 0) {
            unsigned* c = cnt + u.pm * 8;
            (void)__hip_atomic_fetch_add(c, 1u, __ATOMIC_RELAXED, __HIP_MEMORY_SCOPE_AGENT);
            unsigned sp = 0u;
            while (__hip_atomic_load(c, __ATOMIC_RELAXED, __HIP_MEMORY_SCOPE_AGENT) < 4u && ++sp < (1u << 20)) __builtin_amdgcn_s_sleep(2);
        }
        asm volatile("s_waitcnt vmcnt(0) lgkmcnt(0)" ::: "memory"); __builtin_amdgcn_s_barrier(); asm volatile("" ::: "memory");
        f32x4 fgv[2][2];
#pragma unroll
        for (int bj = 0; bj < 2; ++bj)
#pragma unroll
            for (int n = 0; n < 2; ++n) fgv[bj][n] = *(const f32x4*)(fg + col0 + bj * HALF + 4 * n);
#pragma unroll
        for (int ai = 0; ai < 2; ++ai)
#pragma unroll
            for (int m = 0; m < 4; ++m) {
                const int lrow = ai * HALF + wr * 64 + m * 16 + fr;
                const float sq = __hip_atomic_load(ssq + (grow0 + lrow), __ATOMIC_RELAXED, __HIP_MEMORY_SCOPE_AGENT);
                const float ri = 1.0f / sqrtf(sq * (1.0f / 1024.0f) + 1e-6f);
                float* p = out + (size_t)(grow0 + lrow) * DMODEL + col0;
#pragma unroll
                for (int bj = 0; bj < 2; ++bj) { *(f32x4*)(p + bj * HALF) = acc[ai][bj][m][0] * ri * fgv[bj][0]; *(f32x4*)(p + bj * HALF + 4) = acc[ai][bj][m][1] * ri * fgv[bj][1]; }
            }
    }
};
template <class Epi, class Sched, bool ALIGN_EPI = false, bool SP2 = false, bool HALFM = false, bool HALFN = false>
__device__ __forceinline__ void gemm_phase(PG8_LAS unsigned char* lds, const Gemm g, const Sched& S, const Epi& E, const int tid) {
    const int wid = __builtin_amdgcn_readfirstlane(tid >> 6), lane = tid & 63, wr = wid >> 2, wc = wid & 3, fr = lane & 15, fq = lane >> 4;
    const int K = g.K, nt = K / BK;
    unsigned voffA[2], voffB[2];
#pragma unroll
    for (int i = 0; i < 2; ++i) { int R, C; stage_rc(tid * 16 + i * 8192, R, C); const int Rb = Epi::PERM ? ((R & ~31) + perm32(R & 31)) : R;
        voffA[i] = (unsigned)(R * K + C) * 2u; voffB[i] = (unsigned)(Rb * K + C) * 2u; }
    const size_t kstep = (size_t)(BK * 2);
    const size_t hstep = (size_t)HALF * K * 2;
    const size_t tstep = g.Nstep ? (size_t)g.Nstep * K * 2 : 2 * hstep, tstepA = (size_t)g.Mstep * K * 2;
    const unsigned ldsw = (unsigned)wid * 1024u;
    const int aoff = lds_byte(wr * 64 + fr, fq * 8), boff = lds_byte(wc * 32 + fr, fq * 8);
#define PG8_SA(b, h) (((b) * 2 + (h)) * HTB)
#define PG8_SB(b, h) ((4 + (b) * 2 + (h)) * HTB)
#define PG8_STAGE(bufoff, gbase, voff) do { _Pragma("unroll") for (int _i = 0; _i < 2; ++_i) \
        __builtin_amdgcn_global_load_lds((const unsigned*)((const char*)(gbase) + (voff)[_i]), (PG8_LAS unsigned*)(lds + (bufoff) + ldsw + _i * 8192), 16, 0, 0); } while (0)
#define PG8_LDA(dst, b, h) do { _Pragma("unroll") for (int m = 0; m < 4; ++m) _Pragma("unroll") for (int k = 0; k < 2; ++k) dst[m][k] = *(const PG8_LAS bf16x8*)(lds + PG8_SA(b, h) + aoff + m * 2048 + k * 1024); } while (0)
#define PG8_LDB(dst, b, h) do { _Pragma("unroll") for (int n = 0; n < 2; ++n) _Pragma("unroll") for (int k = 0; k < 2; ++k) dst[n][k] = *(const PG8_LAS bf16x8*)(lds + PG8_SB(b, h) + boff + n * 2048 + k * 1024); } while (0)
#define PG8_MMA(ai, bj, At, Bt) do { __builtin_amdgcn_s_setprio(1); _Pragma("unroll") for (int m = 0; m < 4; ++m) _Pragma("unroll") for (int n = 0; n < 2; ++n) _Pragma("unroll") for (int k = 0; k < 2; ++k) \
        acc[ai][bj][m][n] = __builtin_amdgcn_mfma_f32_16x16x32_bf16(Bt[n][k], At[m][k], acc[ai][bj][m][n], 0, 0, 0); __builtin_amdgcn_s_setprio(0); } while (0)
#define PG8_WAIT_V(n) asm volatile("s_waitcnt vmcnt(" #n ")" ::: "memory")
#define PG8_WAIT_L(n) asm volatile("s_waitcnt lgkmcnt(" #n ")" ::: "memory")
#define PG8_BAR __builtin_amdgcn_s_barrier()
#define PG8_SCHED __builtin_amdgcn_sched_barrier(0)
    Unit cur, nxt; int ui = 0;
    if (!S.next(0, cur)) return;
    f32x4 acc[2][2][4][2];
#pragma unroll
    for (int a = 0; a < 2; ++a)
#pragma unroll
        for (int b = 0; b < 2; ++b)
#pragma unroll
            for (int m = 0; m < 4; ++m)
#pragma unroll
                for (int n = 0; n < 2; ++n) acc[a][b][m][n] = (f32x4){0.f, 0.f, 0.f, 0.f};
    bf16x8 At[4][2], B0[2][2], B1[2][2];
    const char* cA = (const char*)g.A + (size_t)cur.pm * tstepA; const char* cB = (const char*)g.Bt + (size_t)cur.pn * tstep;
    S.a_ready(cur);
    if constexpr (SP2) {
        PG8_STAGE(PG8_SB(0, 0), cB, voffB); PG8_STAGE(PG8_SB(0, 1), cB + hstep, voffB); PG8_STAGE(PG8_SA(0, 0), cA, voffA); PG8_STAGE(PG8_SA(0, 1), cA + hstep, voffA);
        if (wr == 1) PG8_BAR;
        PG8_WAIT_V(2); PG8_BAR;
        PG8_STAGE(PG8_SB(1, 0), cB + kstep, voffB); PG8_STAGE(PG8_SA(1, 0), cA + kstep, voffA); PG8_STAGE(PG8_SB(1, 1), cB + hstep + kstep, voffB);
        PG8_WAIT_V(6); PG8_BAR;
    } else {
        PG8_STAGE(PG8_SB(0, 0), cB, voffB); PG8_STAGE(PG8_SA(0, 0), cA, voffA); PG8_STAGE(PG8_SB(0, 1), cB + hstep, voffB); PG8_STAGE(PG8_SA(0, 1), cA + hstep, voffA);
        if (wr == 1) PG8_BAR;
        PG8_WAIT_V(4); PG8_BAR;
        PG8_STAGE(PG8_SB(1, 0), cB + kstep, voffB); PG8_STAGE(PG8_SA(1, 0), cA + kstep, voffA); PG8_STAGE(PG8_SB(1, 1), cB + hstep + kstep, voffB);
        PG8_WAIT_V(6); PG8_BAR;
    }
    for (;;) {
        const bool has_next = S.next(ui + 1, nxt);
        const char* nA = has_next ? (const char*)g.A + (size_t)nxt.pm * tstepA : cA; const char* nB = has_next ? (const char*)g.Bt + (size_t)nxt.pn * tstep : cB;
        for (int t = 0; t < nt; t += 2) {
            const bool last = (t == nt - 2);
            const char* a1 = cA + (size_t)(t + 1) * kstep;
            const char* a2 = last ? nA : cA + (size_t)(t + 2) * kstep; const char* b2 = last ? nB : cB + (size_t)(t + 2) * kstep;
            const char* a3 = a2 + kstep; const char* b3 = b2 + kstep;
            if (last && has_next) S.a_ready(nxt);
            if constexpr (SP2) {
            PG8_LDB(B0, 0, 0); if constexpr (!HALFN) PG8_LDB(B1, 0, 1); PG8_SCHED; PG8_LDA(At, 0, 0); PG8_STAGE(PG8_SA(1, 1), a1 + hstep, voffA);
            PG8_WAIT_V(8); PG8_WAIT_L(0); PG8_BAR; PG8_MMA(0, 0, At, B0); if constexpr (!HALFN) PG8_MMA(0, 1, At, B1); PG8_BAR; PG8_SCHED;
            if constexpr (!HALFM) PG8_LDA(At, 0, 1); PG8_STAGE(PG8_SB(0, 0), b2, voffB); PG8_STAGE(PG8_SB(0, 1), b2 + hstep, voffB); PG8_STAGE(PG8_SA(0, 0), a2, voffA);
            PG8_WAIT_V(8); PG8_WAIT_L(0); PG8_BAR; if constexpr (!HALFM) { PG8_MMA(1, 0, At, B0); PG8_MMA(1, 1, At, B1); } PG8_BAR; PG8_SCHED;
            PG8_LDB(B0, 1, 0); if constexpr (!HALFN) PG8_LDB(B1, 1, 1); PG8_SCHED; PG8_LDA(At, 1, 0); PG8_STAGE(PG8_SA(0, 1), a2 + hstep, voffA);
            PG8_WAIT_V(8); PG8_WAIT_L(0); PG8_BAR; PG8_MMA(0, 0, At, B0); if constexpr (!HALFN) PG8_MMA(0, 1, At, B1); PG8_BAR; PG8_SCHED;
            if constexpr (!HALFM) PG8_LDA(At, 1, 1); PG8_STAGE(PG8_SB(1, 0), b3, voffB); PG8_STAGE(PG8_SB(1, 1), b3 + hstep, voffB); PG8_STAGE(PG8_SA(1, 0), a3, voffA);
            PG8_WAIT_V(8); PG8_WAIT_L(0); PG8_BAR; if constexpr (!HALFM) { PG8_MMA(1, 0, At, B0); PG8_MMA(1, 1, At, B1); } PG8_BAR; PG8_SCHED;
            } else {
            PG8_LDB(B0, 0, 0); PG8_SCHED; PG8_LDA(At, 0, 0); PG8_STAGE(PG8_SA(1, 1), a1 + hstep, voffA);
            PG8_WAIT_L(8); PG8_BAR; PG8_WAIT_L(0); PG8_MMA(0, 0, At, B0); PG8_BAR; PG8_SCHED;
            PG8_LDB(B1, 0, 1); PG8_STAGE(PG8_SB(0, 0), b2, voffB);
            PG8_BAR; PG8_WAIT_L(0); PG8_MMA(0, 1, At, B1); PG8_BAR;
            PG8_LDA(At, 0, 1); PG8_STAGE(PG8_SA(0, 0), a2, voffA);
            PG8_BAR; PG8_WAIT_L(0); PG8_MMA(1, 0, At, B0); PG8_BAR; PG8_SCHED;
            PG8_STAGE(PG8_SB(0, 1), b2 + hstep, voffB);
            PG8_WAIT_V(6); PG8_BAR; PG8_MMA(1, 1, At, B1); PG8_BAR;
            PG8_LDB(B0, 1, 0); PG8_SCHED; PG8_LDA(At, 1, 0); PG8_STAGE(PG8_SA(0, 1), a2 + hstep, voffA);
            PG8_WAIT_L(8); PG8_BAR; PG8_WAIT_L(0); PG8_MMA(0, 0, At, B0); PG8_BAR; PG8_SCHED;
            PG8_LDB(B1, 1, 1); PG8_STAGE(PG8_SB(1, 0), b3, voffB);
            PG8_BAR; PG8_WAIT_L(0); PG8_MMA(0, 1, At, B1); PG8_BAR;
            PG8_LDA(At, 1, 1); PG8_STAGE(PG8_SA(1, 0), a3, voffA);
            PG8_BAR; PG8_WAIT_L(0); PG8_MMA(1, 0, At, B0); PG8_BAR; PG8_SCHED;
            PG8_STAGE(PG8_SB(1, 1), b3 + hstep, voffB);
            PG8_WAIT_V(6); PG8_BAR; PG8_MMA(1, 1, At, B1); PG8_BAR;
            }
        }
        if constexpr (ALIGN_EPI) { if (wr == 0) PG8_BAR; }
        if constexpr (!Epi::AFTER_DRAIN) { E(acc, cur, wr, wc, fr, fq); S.done(cur); }
        if (!has_next) break;
#pragma unroll
        for (int a = 0; a < 2; ++a)
#pragma unroll
            for (int b = 0; b < 2; ++b)
#pragma unroll
                for (int m = 0; m < 4; ++m)
#pragma unroll
                    for (int n = 0; n < 2; ++n) acc[a][b][m][n] = (f32x4){0.f, 0.f, 0.f, 0.f};
        cur = nxt; cA = nA; cB = nB; ++ui;
        if constexpr (ALIGN_EPI) { if (wr == 1) PG8_BAR; }
    }
    PG8_WAIT_V(0);
    if constexpr (!ALIGN_EPI) { if (wr == 0) PG8_BAR; }
    PG8_BAR;
    if constexpr (Epi::AFTER_DRAIN) { E.fused(acc, cur, wr, wc, fr, fq, lds, wid, lane); S.done(cur); }
#undef PG8_SA
#undef PG8_SB
#undef PG8_STAGE
#undef PG8_LDA
#undef PG8_LDB
#undef PG8_MMA
#undef PG8_WAIT_V
#undef PG8_WAIT_L
#undef PG8_BAR
#undef PG8_SCHED
}
}
using pg8::MLAT; using pg8::MCTX; using pg8::MTOT; using pg8::DMODEL; using pg8::NZ; using pg8::NUP; using pg8::FFD; using pg8::MODW;
constexpr int NWAVES = 8, NTHREADS = 512, DEPTH = 2, NSEG = 9, NINSRC = 2848;
constexpr int LDS_BYTES = 147456;
constexpr int RING_BYTES = 131072;
constexpr int MISC_OFF = LDS_BYTES - 256;
#ifndef MK_ONE_LAUNCH
#define MK_ONE_LAUNCH 0
#endif
constexpr int ZC_NAQ = 0, ZC_NAK = 256, ZC_NAV = 512, ZC_WAQ = 768, ZC_WAK = 1024, ZC_WAV = 1152, ZC_GQ = 1280, ZC_GK = 1536, ZC_GV = 1792, ZC_GO = 2304, ZC_GF = 2816, ZC_GB = 3072;
constexpr size_t MiB = 1u << 20, KiB = 1u << 10;
constexpr size_t WS_CTL = 0, CTL_ZERO_BYTES = 256 * KiB;
constexpr size_t WS_MOD = 1 * MiB;
constexpr size_t WS_BIN = 1536 * KiB;
constexpr size_t WS_BUP = 1792 * KiB;
constexpr size_t WS_SSQA = 64 * KiB, WS_SSQB = 160 * KiB;
constexpr size_t WS_ROPE = 3456 * KiB;
constexpr size_t WS_WIN = 4 * MiB;
constexpr size_t WS_WOUT = 17 * MiB;
constexpr size_t WS_WUP = 21 * MiB;
constexpr size_t WS_WDN = 43 * MiB;
constexpr size_t WS_XC = 54 * MiB;
constexpr size_t WS_XM = 62 * MiB;
constexpr size_t WS_Y = 98 * MiB;
constexpr size_t WS_Z = 134 * MiB;
constexpr size_t WS_XB1 = 222 * MiB;
constexpr size_t WS_END = 254 * MiB;
constexpr int CW_BAR = 4096;
constexpr int CW_UPC = 12288;
constexpr int CW_GLAP = 59392;
constexpr int CW_FIN = 11520;
constexpr int CW_FQ = 11264;
constexpr int CW_QUEUE = 8192;

#define GAS __attribute__((address_space(1)))
#define LAS __attribute__((address_space(3)))
typedef unsigned short bf16;
typedef unsigned v4u __attribute__((ext_vector_type(4)));
typedef unsigned v2u __attribute__((ext_vector_type(2)));
typedef float f32x4 __attribute__((ext_vector_type(4)));
#define LDS_WAIT() asm volatile("s_waitcnt lgkmcnt(0)" ::: "memory")
__device__ __forceinline__ unsigned f2bf(float f) { unsigned u = __builtin_bit_cast(unsigned, f); return (u + 0x7fffu + ((u >> 16) & 1u)) >> 16; }
__device__ __forceinline__ unsigned pk2(float lo, float hi) { return f2bf(lo) | (f2bf(hi) << 16); }
__device__ __forceinline__ float bflo(unsigned w) { return __builtin_bit_cast(float, w << 16); }
__device__ __forceinline__ float bfhi(unsigned w) { return __builtin_bit_cast(float, w & 0xffff0000u); }
__device__ __forceinline__ float bf1(bf16 b) { return __builtin_bit_cast(float, (unsigned)b << 16); }
__device__ __forceinline__ float dpp_add(float v, int ctrl_sel) {
    const int x = __builtin_bit_cast(int, v); int y;
    if (ctrl_sel == 0) y = __builtin_amdgcn_update_dpp(x, x, 0xB1, 0xF, 0xF, true);
    else if (ctrl_sel == 1) y = __builtin_amdgcn_update_dpp(x, x, 0x4E, 0xF, 0xF, true);
    else if (ctrl_sel == 2) y = __builtin_amdgcn_update_dpp(x, x, 0x141, 0xF, 0xF, true);
    else y = __builtin_amdgcn_update_dpp(x, x, 0x140, 0xF, 0xF, true);
    return v + __builtin_bit_cast(float, y);
}
__device__ __forceinline__ float wave_sum(float v, int lane) {
    (void)lane;
    v = dpp_add(v, 0); v = dpp_add(v, 1); v = dpp_add(v, 2); v = dpp_add(v, 3);
    return xsum_16_32(v);
}
__device__ __forceinline__ float wave_max(float v, int lane) {
#pragma unroll
    for (int o = 1; o < 64; o <<= 1) v = fmaxf(v, lxor(v, lane, o));
    return v;
}
#define XB_TMO      128
#define XB_XCNT(j)  (256  + 64 * (j))
#define XB_XSUB(j)  (1280 + 64 * (j))
#define XB_XGEN(j)  (2304 + 64 * (j))
#define XB_TOP      3328
#define XB_TOPGEN   3392
#define XCD_BAR_WORDS 3456
#define XB_SPIN_CAP (1u << 18)

__device__ __forceinline__ unsigned xb_ld(unsigned* p)              { return __hip_atomic_load(p, __ATOMIC_RELAXED, __HIP_MEMORY_SCOPE_AGENT); }
__device__ __forceinline__ unsigned xb_add(unsigned* p, unsigned v) { return __hip_atomic_fetch_add(p, v, __ATOMIC_RELAXED, __HIP_MEMORY_SCOPE_AGENT); }
__device__ __forceinline__ unsigned xb_xcc_id() { return (unsigned)__builtin_amdgcn_s_getreg((3 << 11) | 20) & 0xFu; }
#define XB_SPIN(cond, bar) do { unsigned _sp = 0; while (cond) { __builtin_amdgcn_s_sleep(4); \
    if ((++_sp & 255u) == 0u) { if (xb_ld(&(bar)[XB_TMO])) break; if (_sp > XB_SPIN_CAP) { atomicAdd(&(bar)[XB_TMO], 1u); break; } } } } while (0)

struct XcdBarrier {
    unsigned* bar; unsigned x;
    volatile LAS unsigned* st;
};

__device__ __forceinline__ XcdBarrier xcd_barrier_post(unsigned* bar, volatile LAS unsigned* st) {
    XcdBarrier b; b.bar = bar; b.x = xb_xcc_id(); b.st = st;
    if (threadIdx.x == 0) (void)xb_add(&bar[XB_XCNT(b.x)], 1u);
    return b;
}
__device__ __forceinline__ void xcd_barrier_complete(unsigned* bar, unsigned x, unsigned& nloc, unsigned& nx) {
    const unsigned G = gridDim.x * gridDim.y * gridDim.z;
    unsigned sum, cnt, mine, sp = 0u;
    for (;;) {
        sum = 0u; cnt = 0u; mine = 0u;
#pragma unroll
        for (unsigned j = 0; j < 16; ++j) { const unsigned c = xb_ld(&bar[XB_XCNT(j)]); sum += c; cnt += (c > 0u) ? 1u : 0u; mine = (j == x) ? c : mine; }
        if (sum == G) break;
        __builtin_amdgcn_s_sleep(1);
        if ((++sp & 255u) == 0u) { if (xb_ld(&bar[XB_TMO])) break; if (sp > XB_SPIN_CAP) { atomicAdd(&bar[XB_TMO], 1u); break; } }
    }
    nloc = mine > 0u ? mine : 1u; nx = cnt > 0u ? cnt : 1u;
}

__device__ __forceinline__ void xcd_barrier(const XcdBarrier& b, int wave_id) {
    int ln_; asm volatile("v_mbcnt_lo_u32_b32 %0, -1, 0\n\tv_mbcnt_hi_u32_b32 %0, -1, %0" : "=v"(ln_));
    const bool leader_thread = (wave_id == 0) && (ln_ == 0);
    asm volatile("s_waitcnt vmcnt(0)" ::: "memory");
    __syncthreads();
    if (leader_thread) {
        unsigned* bar = b.bar; unsigned bx_ = b.x; asm volatile("; barrier roots re-derived at every call (no per-lane address registers live across phases)" : "+s"(bar), "+s"(bx_));
        __builtin_amdgcn_s_waitcnt(0);
        unsigned nloc = b.st[0], nx = b.st[1];
        if (nloc == 0u) { xcd_barrier_complete(bar, bx_, nloc, nx); b.st[0] = nloc; b.st[1] = nx; }
        const unsigned old = xb_add(&bar[XB_XSUB(bx_)], 1u);
        const unsigned gen = old / nloc;
        if (old + 1u == (gen + 1u) * nloc) {
            __builtin_amdgcn_fence(__ATOMIC_RELEASE, "agent");
            asm volatile("buffer_inv sc1" ::: "memory");
            asm volatile("s_waitcnt vmcnt(0)" ::: "memory");
            const unsigned og = xb_add(&bar[XB_TOP], 1u);
            const unsigned tg = og / nx;
            if (og + 1u == (tg + 1u) * nx) xb_add(&bar[XB_TOPGEN], 1u);
            else XB_SPIN(xb_ld(&bar[XB_TOPGEN]) == tg, bar);
            xb_add(&bar[XB_XGEN(bx_)], 1u);
            __builtin_amdgcn_fence(__ATOMIC_ACQUIRE, "workgroup");
        } else {
            asm volatile("s_waitcnt vmcnt(0)\n\tbuffer_inv sc1" ::: "memory");
            XB_SPIN(xb_ld(&bar[XB_XGEN(bx_)]) == gen, bar);
            asm volatile("s_waitcnt vmcnt(0)" ::: "memory");
            __builtin_amdgcn_fence(__ATOMIC_ACQUIRE, "workgroup");
        }
    }
    __syncthreads();
}

__device__ __forceinline__ void cnt_signal(unsigned* cnt, int tid) {
    asm volatile("s_waitcnt vmcnt(0)" ::: "memory");
    __syncthreads();
    if (tid == 0) {
        __builtin_amdgcn_fence(__ATOMIC_RELEASE, "agent");
        asm volatile("s_waitcnt vmcnt(0)" ::: "memory");
        (void)xb_add(cnt, 1u);
    }
}
__device__ __forceinline__ void cnt_wait(unsigned* cnt, unsigned target, int tid) {
    if (tid == 0) {
        unsigned sp = 0u;
        while (xb_ld(cnt) < target && ++sp < (1u << 24)) __builtin_amdgcn_s_sleep(2);
        __builtin_amdgcn_fence(__ATOMIC_ACQUIRE, "agent");
        asm volatile("s_waitcnt vmcnt(0)" ::: "memory");
    }
    __syncthreads();
}

typedef short bf16x8 __attribute__((ext_vector_type(8)));
typedef short s16x4 __attribute__((ext_vector_type(4)));
typedef short v4i16_t __attribute__((ext_vector_type(4)));
constexpr int VS_STRIDE = 160;
constexpr int VS_BYTES = 64 * VS_STRIDE;
constexpr float LOG2E = 1.4426950408889634f;
__device__ __forceinline__ float ex2(float x) { return __builtin_amdgcn_exp2f(x); }
__device__ __forceinline__ unsigned cvtpk(float lo, float hi) { typedef float f2 __attribute__((ext_vector_type(2))); typedef __bf16 b2 __attribute__((ext_vector_type(2))); f2 v = {lo, hi}; b2 b = __builtin_convertvector(v, b2); return __builtin_bit_cast(unsigned, b); }
__device__ __forceinline__ __amdgpu_buffer_rsrc_t z_rsrc(const bf16* Z) { return __builtin_amdgcn_make_buffer_rsrc((void*)Z, 0, (int)((size_t)MTOT * NZ * 2), 0x00020000); }
__device__ __forceinline__ void load_k(const bf16* Z, const int (&krow)[4], int kcol, int lane, bf16x8 (&kf)[8]) {
    const __amdgpu_buffer_rsrc_t rs = z_rsrc(Z); const int vo = (lane & 15) * (NZ * 2) + (lane >> 4) * 16;
#pragma unroll
    for (int T = 0; T < 4; ++T) { const int so = krow[T] * (NZ * 2) + kcol * 2;
        kf[2 * T] = __builtin_bit_cast(bf16x8, __builtin_amdgcn_raw_buffer_load_b128(rs, vo, so, 0)); kf[2 * T + 1] = __builtin_bit_cast(bf16x8, __builtin_amdgcn_raw_buffer_load_b128(rs, vo, so + 64, 0)); }
}
__device__ __forceinline__ void load_v(const bf16* Z, const int (&krow)[4], int vcol, int lane, v4u (&vr)[8]) {
    const __amdgpu_buffer_rsrc_t rs = z_rsrc(Z); const int vo = (lane >> 3) * (NZ * 2) + (lane & 7) * 16;
#pragma unroll
    for (int T = 0; T < 4; ++T)
#pragma unroll
        for (int i = 0; i < 2; ++i) vr[2 * T + i] = __builtin_amdgcn_raw_buffer_load_b128(rs, vo, (krow[T] + 8 * i) * (NZ * 2) + vcol * 2, 0);
}
__device__ __forceinline__ void stage_v(LAS unsigned char* vs, int lane, const v4u (&vr)[8]) {
#pragma unroll
    for (int T = 0; T < 4; ++T)
#pragma unroll
        for (int i = 0; i < 2; ++i) *(LAS v4u*)(vs + (16 * T + 8 * i + (lane >> 3)) * VS_STRIDE + (lane & 7) * 16) = vr[2 * T + i];
}
template <bool RAW> __device__ __forceinline__ void softmax_pv(LAS unsigned char* vs, int lane, f32x4 (&s)[4], f32x4 (&o)[4], float& m, float& l, float csc) {
    float mx = fmaxf(fmaxf(fmaxf(s[0][0], s[0][1]), fmaxf(s[0][2], s[0][3])), fmaxf(fmaxf(s[1][0], s[1][1]), fmaxf(s[1][2], s[1][3])));
    mx = fmaxf(mx, fmaxf(fmaxf(fmaxf(s[2][0], s[2][1]), fmaxf(s[2][2], s[2][3])), fmaxf(fmaxf(s[3][0], s[3][1]), fmaxf(s[3][2], s[3][3]))));
    mx = xmax_16_32(mx);
    if (RAW) mx *= csc;
    const float mn = fmaxf(m, mx), alpha = ex2(m - mn); m = mn;
    float ls = 0.f;
#pragma unroll
    for (int T = 0; T < 4; ++T)
#pragma unroll
        for (int r = 0; r < 4; ++r) { s[T][r] = RAW ? ex2(__builtin_fmaf(s[T][r], csc, -mn)) : ex2(s[T][r] - mn); ls += s[T][r]; }
    l = l * alpha + ls;
#pragma unroll
    for (int dt = 0; dt < 4; ++dt) o[dt] = o[dt] * alpha;
    v4u pw[2];
#pragma unroll
    for (int ks = 0; ks < 2; ++ks) { pw[ks].x = cvtpk(s[2 * ks][0], s[2 * ks][1]); pw[ks].y = cvtpk(s[2 * ks][2], s[2 * ks][3]); pw[ks].z = cvtpk(s[2 * ks + 1][0], s[2 * ks + 1][1]); pw[ks].w = cvtpk(s[2 * ks + 1][2], s[2 * ks + 1][3]); }
    const int g = lane >> 4, qq = (lane & 15) >> 2, p = lane & 3;
    const LAS unsigned char* vb = vs + (4 * g + qq) * VS_STRIDE + 8 * p;
#pragma unroll
    for (int dt = 0; dt < 4; ++dt)
#pragma unroll
        for (int ks = 0; ks < 2; ++ks) {
            const s16x4 lo = __builtin_bit_cast(s16x4, __builtin_amdgcn_ds_read_tr16_b64_v4i16((LAS v4i16_t*)(vb + (32 * ks) * VS_STRIDE + 32 * dt)));
            const s16x4 hi = __builtin_bit_cast(s16x4, __builtin_amdgcn_ds_read_tr16_b64_v4i16((LAS v4i16_t*)(vb + (32 * ks + 16) * VS_STRIDE + 32 * dt)));
            const bf16x8 va = (bf16x8){lo[0], lo[1], lo[2], lo[3], hi[0], hi[1], hi[2], hi[3]};
            o[dt] = __builtin_amdgcn_mfma_f32_16x16x32_bf16(va, __builtin_bit_cast(bf16x8, pw[ks]), o[dt], 0, 0, 0);
        }
}
__device__ __forceinline__ void qk4(const bf16x8 (&kf)[8], const bf16x8 (&qf)[2], f32x4 (&s)[4]) {
#pragma unroll
    for (int T = 0; T < 4; ++T) { f32x4 z = (f32x4){0.f, 0.f, 0.f, 0.f};
        z = __builtin_amdgcn_mfma_f32_16x16x32_bf16(kf[2 * T], qf[0], z, 0, 0, 0);
        s[T] = __builtin_amdgcn_mfma_f32_16x16x32_bf16(kf[2 * T + 1], qf[1], z, 0, 0, 0); }
}
__device__ __forceinline__ void attn_store(bf16* Y, int row0, int ycol, int lane, const f32x4 (&o)[4], float l) {
    l = xsum_16_32(l);
    const float rl = 1.0f / l; const int q = lane & 15, g = lane >> 4;
#pragma unroll
    for (int dt = 0; dt < 4; ++dt) { v2u w; w.x = cvtpk(o[dt][0] * rl, o[dt][1] * rl); w.y = cvtpk(o[dt][2] * rl, o[dt][3] * rl);
        *(v2u*)(Y + (size_t)(row0 + q) * 1024 + ycol + 16 * dt + 4 * g) = w; }
}
__device__ __forceinline__ void load_q(const bf16* Z, int row0, int qcol, int lane, bf16x8 (&qf)[2]) {
    const bf16* p = Z + (size_t)(row0 + (lane & 15)) * NZ + qcol + 8 * (lane >> 4);
    qf[0] = *(const bf16x8*)p; qf[1] = *(const bf16x8*)(p + 32);
}
__device__ __forceinline__ void na_unit(const bf16* Z, bf16* Y, const LAS float* rpbL, LAS unsigned char* vs, int lane, int unit, int h) {
    const bool lat = unit < MLAT / 16;
    const int row0 = unit * 16;
    int b, r = 0, c0 = 0; if (lat) { b = row0 >> 11; const int t0 = row0 & 2047; r = t0 >> 6; c0 = t0 & 63; } else b = (row0 - MLAT) >> 8;
    const int rs = min(max(r - 4, 0), 24), u0 = min(max(c0 - 8, 0), 32);
    const int q = lane & 15, g = lane >> 4, c = c0 + q, cs = min(max(c - 8, 0), 48);
    const float csc = 0.125f * LOG2E;
    bf16x8 qf[2]; load_q(Z, row0, ZC_NAQ + h * 64, lane, qf);
    int coff[2][4];
#pragma unroll
    for (int hf = 0; hf < 2; ++hf)
#pragma unroll
        for (int rg = 0; rg < 4; ++rg) { const int kc = u0 + 16 * hf + 4 * g + rg; coff[hf][rg] = ((kc >= cs) && (kc < cs + 16)) ? kc - c + 15 : 31; }
    f32x4 o[4]; float m = -1e30f, l = 0.f;
#pragma unroll
    for (int dt = 0; dt < 4; ++dt) o[dt] = (f32x4){0.f, 0.f, 0.f, 0.f};
    const int nch = lat ? 8 : 4, nloc = lat ? 4 : 0;
    int krow[4]; bf16x8 kA[8], kB[8]; v4u vA[8], vB[8];
#define NA_KROW(ch) do { if ((ch) < nloc) { _Pragma("unroll") for (int T = 0; T < 4; ++T) krow[T] = b * 2048 + (rs + 2 * (ch) + (T >> 1)) * 64 + u0 + 16 * (T & 1); } \
                         else { _Pragma("unroll") for (int T = 0; T < 4; ++T) krow[T] = MLAT + b * 256 + 64 * ((ch) - nloc) + 16 * T; } } while (0)
#define NA_STEP(ch_, kX, vX) do { const int ch = (ch_); f32x4 s[4]; qk4(kX, qf, s); \
        if (ch + 2 < nch) { NA_KROW(ch + 2); load_k(Z, krow, ZC_NAK + h * 64, lane, kX); } \
        if (ch < nloc) { _Pragma("unroll") for (int T = 0; T < 4; ++T) { const int wrow = rs + 2 * ch + (T >> 1); const LAS float* bp = rpbL + (h * 15 + (wrow - r + 7)) * 32; \
                _Pragma("unroll") for (int rg = 0; rg < 4; ++rg) s[T][rg] = __builtin_fmaf(s[T][rg], csc, bp[coff[T & 1][rg]]); } } \
        stage_v(vs, lane, vX); \
        if (ch + 2 < nch) load_v(Z, krow, ZC_NAV + h * 64, lane, vX); \
        if (ch < nloc) softmax_pv<false>(vs, lane, s, o, m, l, csc); else softmax_pv<true>(vs, lane, s, o, m, l, csc); } while (0)
    NA_KROW(0); load_k(Z, krow, ZC_NAK + h * 64, lane, kA); load_v(Z, krow, ZC_NAV + h * 64, lane, vA);
    NA_KROW(1); load_k(Z, krow, ZC_NAK + h * 64, lane, kB); load_v(Z, krow, ZC_NAV + h * 64, lane, vB);
    for (int c2 = 0; c2 < nch; c2 += 2) { NA_STEP(c2, kA, vA); NA_STEP(c2 + 1, kB, vB); }
#undef NA_STEP
#undef NA_KROW
    attn_store(Y, row0, h * 64, lane, o, l);
}
__device__ __forceinline__ void wa_unit(const bf16* Z, bf16* Y, const float* sink, LAS unsigned char* vs, int lane, int unit, int kvh) {
    const bool lat = unit < MLAT / 16;
    const int row0 = unit * 16;
    int b, t0 = 0; if (lat) { b = row0 >> 11; t0 = row0 & 2047; } else b = (row0 - MLAT) >> 8;
    const int q = lane & 15, g = lane >> 4, t = t0 + q;
    const float csc = 0.125f * LOG2E;
    bf16x8 qf0[2], qf1[2]; load_q(Z, row0, ZC_WAQ + (2 * kvh) * 64, lane, qf0); load_q(Z, row0, ZC_WAQ + (2 * kvh + 1) * 64, lane, qf1);
    f32x4 o0[4], o1[4];
    float m0 = sink[2 * kvh] * LOG2E, m1 = sink[2 * kvh + 1] * LOG2E, l0 = (g == 0) ? 1.f : 0.f, l1 = l0;
#pragma unroll
    for (int dt = 0; dt < 4; ++dt) { o0[dt] = (f32x4){0.f, 0.f, 0.f, 0.f}; o1[dt] = (f32x4){0.f, 0.f, 0.f, 0.f}; }
    const int nch = lat ? 9 : 4, nloc = lat ? 17 : 0, nreal = lat ? 33 : 16;
    int krow[4]; bf16x8 kf[8]; v4u vr[8];
#define WA_KROW(ch) do { _Pragma("unroll") for (int T = 0; T < 4; ++T) { const int j = 4 * (ch) + T; int kr; \
        if (j < nloc) { const int s0 = t0 - 128 + 16 * j; kr = b * 2048 + min(max(s0, 0), 2032); } else { const int jc = min(j - nloc, 15); kr = MLAT + b * 256 + 16 * jc; } krow[T] = kr; } } while (0)
    WA_KROW(0); load_k(Z, krow, ZC_WAK + kvh * 64, lane, kf); load_v(Z, krow, ZC_WAV + kvh * 64, lane, vr);
    for (int ch = 0; ch < nch; ++ch) {
        f32x4 sa[4], sb[4]; qk4(kf, qf0, sa); qk4(kf, qf1, sb);
        if (ch + 1 < nch) { WA_KROW(ch + 1); load_k(Z, krow, ZC_WAK + kvh * 64, lane, kf); }
#pragma unroll
        for (int T = 0; T < 4; ++T) { const int j = 4 * ch + T;
            bool tv;
            if (j < nloc) { const int s0 = t0 - 128 + 16 * j; tv = (s0 >= 0) && (s0 < 2048); } else tv = j < nreal;
            if (!tv) { sa[T] = (f32x4){-INFINITY, -INFINITY, -INFINITY, -INFINITY}; sb[T] = sa[T]; }
            else if (lat && (j == 0 || j == 16)) {
#pragma unroll
                for (int rg = 0; rg < 4; ++rg) { const bool ok = (j == 0) ? (4 * g + rg >= q) : (4 * g + rg <= q); sa[T][rg] = ok ? sa[T][rg] : -INFINITY; sb[T][rg] = ok ? sb[T][rg] : -INFINITY; }
            }
        }
        stage_v(vs, lane, vr);
        if (ch + 1 < nch) load_v(Z, krow, ZC_WAV + kvh * 64, lane, vr);
        softmax_pv<true>(vs, lane, sa, o0, m0, l0, csc);
        softmax_pv<true>(vs, lane, sb, o1, m1, l1, csc);
    }
#undef WA_KROW
    attn_store(Y, row0, 256 + (2 * kvh) * 64, lane, o0, l0);
    attn_store(Y, row0, 256 + (2 * kvh + 1) * 64, lane, o1, l1);
}

constexpr int AT_NS = 5, AT_STAGE = 16384, AT_RING = AT_NS * AT_STAGE;
__device__ __forceinline__ void at_dma(const bf16* Z, LAS unsigned char* stage, int wave, int lane, int tokrow, int kcol, int vcol) {
    const __amdgpu_buffer_rsrc_t rs = z_rsrc(Z); const int vo = (lane >> 3) * (NZ * 2) + (((lane & 7) ^ (lane >> 3)) << 4);
    __builtin_amdgcn_raw_ptr_buffer_load_lds(rs, (LAS unsigned*)(stage + wave * 1024), 16, vo, tokrow * (NZ * 2) + kcol * 2, 0, 0);
    __builtin_amdgcn_raw_ptr_buffer_load_lds(rs, (LAS unsigned*)(stage + 8192 + wave * 1024), 16, vo, tokrow * (NZ * 2) + vcol * 2, 0, 0);
}
#define AT_WAITV(n) asm volatile("s_waitcnt vmcnt(" #n ")" ::: "memory")
__device__ __forceinline__ void at_kfrag(const LAS unsigned char* const (&sk)[4], const int (&kb)[4], int lane, bf16x8 (&kf)[8]) {
    const int key = lane & 15, g = lane >> 4;
#pragma unroll
    for (int T = 0; T < 4; ++T) { const LAS unsigned char* p = sk[T] + (kb[T] + key) * 128;
        kf[2 * T] = *(const LAS bf16x8*)(p + ((g ^ (key & 7)) << 4)); kf[2 * T + 1] = *(const LAS bf16x8*)(p + (((g + 4) ^ (key & 7)) << 4)); }
}
template <bool RAW> __device__ __forceinline__ void softmax1(int lane, f32x4 (&s)[4], f32x4 (&o)[4], float& m, float& l, float csc, v4u (&pw)[2]) {
    float mx = fmaxf(fmaxf(fmaxf(s[0][0], s[0][1]), fmaxf(s[0][2], s[0][3])), fmaxf(fmaxf(s[1][0], s[1][1]), fmaxf(s[1][2], s[1][3])));
    mx = fmaxf(mx, fmaxf(fmaxf(fmaxf(s[2][0], s[2][1]), fmaxf(s[2][2], s[2][3])), fmaxf(fmaxf(s[3][0], s[3][1]), fmaxf(s[3][2], s[3][3]))));
    mx = xmax_16_32(mx);
    if (RAW) mx *= csc;
    const float mn = fmaxf(m, mx), alpha = ex2(m - mn); m = mn;
    float ls = 0.f;
#pragma unroll
    for (int T = 0; T < 4; ++T)
#pragma unroll
        for (int r = 0; r < 4; ++r) { s[T][r] = RAW ? ex2(__builtin_fmaf(s[T][r], csc, -mn)) : ex2(s[T][r] - mn); ls += s[T][r]; }
    l = l * alpha + ls;
#pragma unroll
    for (int dt = 0; dt < 4; ++dt) o[dt] = o[dt] * alpha;
#pragma unroll
    for (int ks = 0; ks < 2; ++ks) { pw[ks].x = cvtpk(s[2 * ks][0], s[2 * ks][1]); pw[ks].y = cvtpk(s[2 * ks][2], s[2 * ks][3]); pw[ks].z = cvtpk(s[2 * ks + 1][0], s[2 * ks + 1][1]); pw[ks].w = cvtpk(s[2 * ks + 1][2], s[2 * ks + 1][3]); }
}
__device__ __forceinline__ void at_pv(const LAS unsigned char* sv0, const LAS unsigned char* sv1, int v00, int v01, int lane, const v4u (&pw)[2], f32x4 (&o)[4]) {
    const int g = lane >> 4, qq = (lane & 15) >> 2, p = lane & 3, r7 = (4 * g + qq) & 7;
    const LAS unsigned char* vb0 = sv0 + (v00 + 4 * g + qq) * 128 + (p & 1) * 8; const LAS unsigned char* vb1 = sv1 + (v01 + 4 * g + qq) * 128 + (p & 1) * 8;
#pragma unroll
    for (int dt = 0; dt < 4; ++dt) {
        const int sw = (((p >> 1) + 2 * dt) ^ r7) << 4;
#pragma unroll
        for (int ks = 0; ks < 2; ++ks) { const LAS unsigned char* vb = ks ? vb1 : vb0;
            const s16x4 lo = __builtin_bit_cast(s16x4, __builtin_amdgcn_ds_read_tr16_b64_v4i16((LAS v4i16_t*)(vb + sw)));
            const s16x4 hi = __builtin_bit_cast(s16x4, __builtin_amdgcn_ds_read_tr16_b64_v4i16((LAS v4i16_t*)(vb + 16 * 128 + sw)));
            const bf16x8 va = (bf16x8){lo[0], lo[1], lo[2], lo[3], hi[0], hi[1], hi[2], hi[3]};
            o[dt] = __builtin_amdgcn_mfma_f32_16x16x32_bf16(va, __builtin_bit_cast(bf16x8, pw[ks]), o[dt], 0, 0, 0);
        }
    }
}
__device__ __forceinline__ void wa_block(const bf16* Z, bf16* Y, const float* sink, LAS unsigned char* ring, int lane, int wave, int b, int blk, int kvh) {
    const bool lat = blk < 16; const int t0b = 128 * blk, t0 = t0b + 16 * wave;
    const int row0 = lat ? b * 2048 + t0 : MLAT + b * 256 + 128 * (blk - 16) + 16 * wave;
    const int q = lane & 15, g = lane >> 4;
    const float csc = 0.125f * LOG2E;
    bf16x8 qf0[2], qf1[2]; load_q(Z, row0, ZC_WAQ + (2 * kvh) * 64, lane, qf0); load_q(Z, row0, ZC_WAQ + (2 * kvh + 1) * 64, lane, qf1);
    asm volatile("" ::: "memory");
    f32x4 o0[4], o1[4]; int g0_ = g; asm volatile("; per-unit" : "+v"(g0_));
    float m0 = sink[2 * kvh] * LOG2E, m1 = sink[2 * kvh + 1] * LOG2E, l0 = (g0_ == 0) ? 1.f : 0.f, l1 = l0;
#pragma unroll
    for (int dt = 0; dt < 4; ++dt) { o0[dt] = (f32x4){0.f, 0.f, 0.f, 0.f}; o1[dt] = (f32x4){0.f, 0.f, 0.f, 0.f}; }
    const int nloc = lat ? 6 : 0, nch = nloc + 4;
    const int kcol = ZC_WAK + kvh * 64, vcol = ZC_WAV + kvh * 64;
#define WB_TOK(c) ((c) < nloc ? b * 2048 + min(max(t0b - 128 + 64 * (c) + 16 * (wave >> 1), 0), 2032) + 8 * (wave & 1) : MLAT + b * 256 + 64 * ((c) - nloc) + 8 * wave)
    at_dma(Z, ring, wave, lane, WB_TOK(0), kcol, vcol); at_dma(Z, ring + AT_STAGE, wave, lane, WB_TOK(1), kcol, vcol);
    int st = 0, st2 = 2;
    for (int i = 0; i < nch; ++i) {
        if (i + 2 < nch) { at_dma(Z, ring + st2 * AT_STAGE, wave, lane, WB_TOK(i + 2), kcol, vcol); AT_WAITV(4); } else if (i + 1 < nch) AT_WAITV(2); else AT_WAITV(0);
        __builtin_amdgcn_s_barrier(); asm volatile("" ::: "memory");
        bool tv[4]; bool any = false;
#pragma unroll
        for (int T = 0; T < 4; ++T) { const int j = 4 * i + T; if (i < nloc) { const int jr = j - wave, s0 = t0b - 128 + 16 * j; tv[T] = (jr >= 0) && (jr <= 16) && (s0 >= 0) && (s0 < 2048); } else tv[T] = true; any = any || tv[T]; }
        if (any) {
            const LAS unsigned char* sk = ring + st * AT_STAGE;
            const LAS unsigned char* const ska[4] = {sk, sk, sk, sk}; const int kb[4] = {0, 16, 32, 48};
            bf16x8 kf[8]; at_kfrag(ska, kb, lane, kf);
            f32x4 sa[4], sb[4]; v4u pa[2], pb[2]; qk4(kf, qf0, sa); qk4(kf, qf1, sb);
#pragma unroll
            for (int T = 0; T < 4; ++T) { const int jr = 4 * i + T - wave;
                if (!tv[T]) { sa[T] = (f32x4){-INFINITY, -INFINITY, -INFINITY, -INFINITY}; sb[T] = sa[T]; }
                else if (i < nloc && (jr == 0 || jr == 16)) {
#pragma unroll
                    for (int rg = 0; rg < 4; ++rg) { const bool ok = (jr == 0) ? (4 * g + rg >= q) : (4 * g + rg <= q); sa[T][rg] = ok ? sa[T][rg] : -INFINITY; sb[T][rg] = ok ? sb[T][rg] : -INFINITY; }
                }
            }
            softmax1<true>(lane, sa, o0, m0, l0, csc, pa); softmax1<true>(lane, sb, o1, m1, l1, csc, pb);
            at_pv(sk + 8192, sk + 8192, 0, 32, lane, pa, o0); at_pv(sk + 8192, sk + 8192, 0, 32, lane, pb, o1);
            asm volatile("s_waitcnt lgkmcnt(0)" ::: "memory");
        }
        st = (st == AT_NS - 1) ? 0 : st + 1; st2 = (st2 == AT_NS - 1) ? 0 : st2 + 1;
    }
#undef WB_TOK
    attn_store(Y, row0, 256 + (2 * kvh) * 64, lane, o0, l0);
    attn_store(Y, row0, 256 + (2 * kvh + 1) * 64, lane, o1, l1);
    asm volatile("s_waitcnt lgkmcnt(0)" ::: "memory"); __builtin_amdgcn_s_barrier(); asm volatile("" ::: "memory");
}
__device__ __forceinline__ void na_block(const bf16* Z, bf16* Y, const LAS float* rpbL, LAS unsigned char* ring, int lane, int wave, int b, int blk, int h) {
    const bool lat = blk < 16;
    const int r = lat ? 2 * blk + (wave >> 2) : 0, c0 = lat ? 16 * (wave & 3) : 0;
    const int row0 = lat ? b * 2048 + r * 64 + c0 : MLAT + b * 256 + 128 * (blk - 16) + 16 * wave;
    const int rsA = min(max(2 * blk - 4, 0), 24), rsB = min(max(2 * blk + 1 - 4, 0), 24);
    const int rs = min(max(r - 4, 0), 24), u0 = min(max(c0 - 8, 0), 32);
    const int nrow = lat ? rsB - rsA + 8 : 0, nch = nrow + 4, off = rs - rsA;
    const int q = lane & 15, g = lane >> 4, c = c0 + q, cs = min(max(c - 8, 0), 48);
    const float csc = 0.125f * LOG2E;
    bf16x8 qf[2]; load_q(Z, row0, ZC_NAQ + h * 64, lane, qf);
    asm volatile("" ::: "memory");
    int coff[2][4];
#pragma unroll
    for (int hf = 0; hf < 2; ++hf)
#pragma unroll
        for (int rg = 0; rg < 4; ++rg) { const int kc = u0 + 16 * hf + 4 * g + rg; coff[hf][rg] = ((kc >= cs) && (kc < cs + 16)) ? kc - c + 15 : 31; }
    f32x4 o[4]; float m = -1e30f, l = 0.f;
#pragma unroll
    for (int dt = 0; dt < 4; ++dt) o[dt] = (f32x4){0.f, 0.f, 0.f, 0.f};
    const int kcol = ZC_NAK + h * 64, vcol = ZC_NAV + h * 64;
#define NB_TOK(ci) ((ci) < nrow ? b * 2048 + (rsA + (ci)) * 64 + 8 * wave : MLAT + b * 256 + 64 * ((ci) - nrow) + 8 * wave)
    at_dma(Z, ring, wave, lane, NB_TOK(0), kcol, vcol); at_dma(Z, ring + AT_STAGE, wave, lane, NB_TOK(1), kcol, vcol);
    int st = 0, st2 = 2, stp = AT_NS - 1;
    for (int i = 0; i < nch; ++i) {
        if (i + 2 < nch) { at_dma(Z, ring + st2 * AT_STAGE, wave, lane, NB_TOK(i + 2), kcol, vcol); AT_WAITV(4); } else if (i + 1 < nch) AT_WAITV(2); else AT_WAITV(0);
        __builtin_amdgcn_s_barrier(); asm volatile("" ::: "memory");
        const LAS unsigned char* sc = ring + st * AT_STAGE; const LAS unsigned char* sp = ring + stp * AT_STAGE;
        if (i < nrow) {
            const int d = i - 1 - off;
            if (d >= 0 && d <= 6 && (d & 1) == 0) {
                const int k = d >> 1;
                const LAS unsigned char* const ska[4] = {sp, sp, sc, sc}; const int kb[4] = {u0, u0 + 16, u0, u0 + 16};
                bf16x8 kf[8]; at_kfrag(ska, kb, lane, kf);
                f32x4 s[4]; v4u pw[2]; qk4(kf, qf, s);
#pragma unroll
                for (int T = 0; T < 4; ++T) { const int wrow = rs + 2 * k + (T >> 1); const LAS float* bp = rpbL + (h * 15 + (wrow - r + 7)) * 32;
#pragma unroll
                    for (int rg = 0; rg < 4; ++rg) s[T][rg] = __builtin_fmaf(s[T][rg], csc, bp[coff[T & 1][rg]]); }
                softmax1<false>(lane, s, o, m, l, csc, pw);
                at_pv(sp + 8192, sc + 8192, u0, u0, lane, pw, o);
                asm volatile("s_waitcnt lgkmcnt(0)" ::: "memory");
            }
        } else {
            const LAS unsigned char* const ska[4] = {sc, sc, sc, sc}; const int kb[4] = {0, 16, 32, 48};
            bf16x8 kf[8]; at_kfrag(ska, kb, lane, kf);
            f32x4 s[4]; v4u pw[2]; qk4(kf, qf, s);
            softmax1<true>(lane, s, o, m, l, csc, pw);
            at_pv(sc + 8192, sc + 8192, 0, 32, lane, pw, o);
            asm volatile("s_waitcnt lgkmcnt(0)" ::: "memory");
        }
        stp = st; st = (st == AT_NS - 1) ? 0 : st + 1; st2 = (st2 == AT_NS - 1) ? 0 : st2 + 1;
    }
#undef NB_TOK
    attn_store(Y, row0, h * 64, lane, o, l);
    asm volatile("s_waitcnt lgkmcnt(0)" ::: "memory"); __builtin_amdgcn_s_barrier(); asm volatile("" ::: "memory");
}

typedef float f32x16 __attribute__((ext_vector_type(16)));
#define MFMA32(a, b, c) __builtin_amdgcn_mfma_f32_32x32x16_bf16((a), (b), (c), 0, 0, 0)
constexpr int GIM_STRIDE = 192;
constexpr int GL_GIM = 0, GL_QIM = 12288, GL_KRI = 21504, GL_EVP = 30720;
constexpr int GL_SB = 31232, GL_SBSZ = 35328;
constexpr int GL_QF = 0, GL_KF = 8192, GL_KIM = 16384, GL_EV = 28672, GL_XF = 29184;
constexpr int GL_VIM = GL_SB + 2 * GL_SBSZ;
constexpr int GL_FLAG = GL_VIM + 4 * 4096;
constexpr int GL_END = GL_FLAG + 256;
constexpr unsigned GL_SPIN_CAP = 1u << 22;
__device__ __forceinline__ s16x4 trr(const LAS unsigned char* p) { return __builtin_bit_cast(s16x4, __builtin_amdgcn_ds_read_tr16_b64_v4i16((LAS v4i16_t*)p)); }
__device__ __forceinline__ bf16x8 mk8(s16x4 lo, s16x4 hi) { return (bf16x8){lo[0], lo[1], lo[2], lo[3], hi[0], hi[1], hi[2], hi[3]}; }
__device__ __forceinline__ bf16x8 pack8(const f32x16& x, int s) {
    v4u w; w.x = cvtpk(x[8 * s], x[8 * s + 1]); w.y = cvtpk(x[8 * s + 2], x[8 * s + 3]); w.z = cvtpk(x[8 * s + 4], x[8 * s + 5]); w.w = cvtpk(x[8 * s + 6], x[8 * s + 7]);
    return __builtin_bit_cast(bf16x8, w);
}
__device__ __forceinline__ unsigned lds_ld(volatile LAS unsigned* p) { return *p; }
__device__ __forceinline__ void gla_chunk_rows(int c, int b, int dir, bool& isctx, int& rbase) {
    isctx = c < 4;
    const int ci = (dir == 0) ? (isctx ? c : c - 4) : (isctx ? 3 - c : 31 - (c - 4));
    const int base_row = isctx ? MLAT + b * 256 + ci * 64 : b * 2048 + ci * 64;
    rbase = dir ? base_row + 63 : base_row;
}
__device__ __forceinline__ void gla_prep(const bf16* Z, int b, int h, int dir, int it, LAS unsigned char* L, int lane) {
    LAS unsigned char* gim = L + it * 15616; LAS unsigned char* qim = gim + 6144; LAS unsigned char* kri = qim + 4608; LAS float* evp = (LAS float*)(kri + 4608);
    volatile LAS unsigned* flag = (volatile LAS unsigned*)(L + GL_FLAG);
    const int r = lane & 31, hh = lane >> 5, rh = (lane >> 4) & 1, qq = (lane & 15) >> 2, p4 = lane & 3;
    const int gcol = (dir ? ZC_GB : ZC_GF) + h * 64, qcol = ZC_GQ + h * 64, kcol = ZC_GK + h * 64;
    const int a_off = qq * GIM_STRIDE + (16 * rh + 4 * p4) * 2;
    const __amdgpu_buffer_rsrc_t zrs = __builtin_amdgcn_make_buffer_rsrc((void*)Z, 0, (int)((size_t)MTOT * NZ * 2), 0x00020000);
    const int vo8 = (dir ? 7 - (lane >> 3) : (lane >> 3)) * (NZ * 2) + (lane & 7) * 16;
    v4u gld[4], qld[4], kld[4];
#define GLA_LOAD_RAW(cc) do { bool ic_; int rb_; gla_chunk_rows((cc), b, dir, ic_, rb_); _Pragma("unroll") for (int i = 0; i < 4; ++i) { const int p0 = 32 * it + 8 * i; const int so = (dir ? rb_ - p0 - 7 : rb_ + p0) * (NZ * 2); \
        gld[i] = __builtin_amdgcn_raw_buffer_load_b128(zrs, vo8, so + gcol * 2, 0); qld[i] = __builtin_amdgcn_raw_buffer_load_b128(zrs, vo8, so + qcol * 2, 0); kld[i] = __builtin_amdgcn_raw_buffer_load_b128(zrs, vo8, so + kcol * 2, 0); } } while (0)
    GLA_LOAD_RAW(0);
    for (int c = 0; c < 36; ++c) {
#pragma unroll
        for (int i = 0; i < 4; ++i) { *(LAS v4u*)(gim + (8 * i + (lane >> 3)) * GIM_STRIDE + (lane & 7) * 16) = gld[i];
            *(LAS v4u*)(qim + (8 * i + (lane >> 3)) * 144 + (lane & 7) * 16) = qld[i]; *(LAS v4u*)(kri + (8 * i + (lane >> 3)) * 144 + (lane & 7) * 16) = kld[i]; }
        if (c + 1 < 36) GLA_LOAD_RAW(c + 1);
        bf16x8 mm[2], mr;
#pragma unroll
        for (int s = 0; s < 2; ++s)
#pragma unroll
            for (int jj = 0; jj < 8; ++jj) { const int j = 16 * s + 8 * hh + jj; mm[s][jj] = (it == 0) ? ((j > r) ? (short)0xBF80 : (short)0) : ((j <= r) ? (short)0x3F80 : (short)0); }
#pragma unroll
        for (int jj = 0; jj < 8; ++jj) mr[jj] = (r == 0) ? (short)0x3F80 : (short)0;
        bf16x8 qf[2][2], kf[2][2];
#pragma unroll
        for (int dt = 0; dt < 2; ++dt) {
            bf16x8 ga[2];
#pragma unroll
            for (int s = 0; s < 2; ++s) { const LAS unsigned char* p = gim + (16 * s + 8 * hh) * GIM_STRIDE + dt * 64 + a_off; ga[s] = mk8(trr(p), trr(p + 4 * GIM_STRIDE)); }
            f32x16 z16;
#pragma unroll
            for (int i = 0; i < 16; ++i) z16[i] = 0.f;
            f32x16 C = MFMA32(ga[0], mm[0], z16); C = MFMA32(ga[1], mm[1], C);
            if (it == 0) {
                f32x16 R = MFMA32(ga[0], mr, z16); R = MFMA32(ga[1], mr, R);
                if (r == 0) {
#pragma unroll
                    for (int g = 0; g < 4; ++g) *(LAS f32x4*)(evp + 32 * dt + 8 * g + 4 * hh) = (f32x4){ex2(R[4 * g] * LOG2E), ex2(R[4 * g + 1] * LOG2E), ex2(R[4 * g + 2] * LOG2E), ex2(R[4 * g + 3] * LOG2E)};
                }
            } else if (r == 31) {
#pragma unroll
                for (int g = 0; g < 4; ++g) *(LAS f32x4*)(evp + 32 * dt + 8 * g + 4 * hh) = (f32x4){ex2(C[4 * g] * LOG2E), ex2(C[4 * g + 1] * LOG2E), ex2(C[4 * g + 2] * LOG2E), ex2(C[4 * g + 3] * LOG2E)};
            }
            f32x16 qt, kt;
#pragma unroll
            for (int g = 0; g < 4; ++g) {
                const v2u qw = *(const LAS v2u*)(qim + r * 144 + (32 * dt + 8 * g + 4 * hh) * 2), kw = *(const LAS v2u*)(kri + r * 144 + (32 * dt + 8 * g + 4 * hh) * 2);
                const float qv[4] = {bflo(qw.x), bfhi(qw.x), bflo(qw.y), bfhi(qw.y)}, kv[4] = {bflo(kw.x), bfhi(kw.x), bflo(kw.y), bfhi(kw.y)};
#pragma unroll
                for (int e = 0; e < 4; ++e) { const float cc = C[4 * g + e] * LOG2E; const float eq = ex2(cc), ek = ex2(-cc);
                    qt[4 * g + e] = qv[e] * eq * 0.125f; kt[4 * g + e] = kv[e] * ek; }
            }
            qf[dt][0] = pack8(qt, 0); qf[dt][1] = pack8(qt, 1); kf[dt][0] = pack8(kt, 0); kf[dt][1] = pack8(kt, 1);
        }
        const int bsel = c & 1; LAS unsigned char* sb = L + GL_SB + bsel * GL_SBSZ;
        { unsigned spins = 0;
          for (;;) { const unsigned d0 = lds_ld(flag + 4 + 4 * bsel), d1 = lds_ld(flag + 5 + 4 * bsel), d2 = lds_ld(flag + 6 + 4 * bsel), d3 = lds_ld(flag + 7 + 4 * bsel);
              const unsigned need = (unsigned)(c > 1 ? c - 1 : 0);
              if ((d0 >= need && d1 >= need && d2 >= need && d3 >= need) || ++spins > GL_SPIN_CAP) break; __builtin_amdgcn_s_sleep(2); } }
        asm volatile("" ::: "memory");
#pragma unroll
        for (int dt = 0; dt < 2; ++dt)
#pragma unroll
            for (int s = 0; s < 2; ++s) {
                *(LAS bf16x8*)(sb + GL_QF + ((it * 2 + dt) * 2 + s) * 1024 + lane * 16) = qf[dt][s]; *(LAS bf16x8*)(sb + GL_KF + ((it * 2 + dt) * 2 + s) * 1024 + lane * 16) = kf[dt][s];
                const v4u w = __builtin_bit_cast(v4u, kf[dt][s]); LAS unsigned char* p = sb + GL_KIM + (r + 32 * it) * GIM_STRIDE + (32 * dt + 16 * s + 4 * hh) * 2;
                *(LAS v2u*)p = (v2u){w.x, w.y}; *(LAS v2u*)(p + 16) = (v2u){w.z, w.w}; }
        ((LAS float*)(sb + GL_EV))[64 * it + lane] = evp[lane];
        asm volatile("s_waitcnt lgkmcnt(0)" ::: "memory");
        if (lane == 0) flag[2 * bsel + it] = (unsigned)(c + 1);
        asm volatile("" ::: "memory");
    }
#undef GLA_LOAD_RAW
}
__device__ __forceinline__ void gla_scan(const bf16* Z, bf16* OG, int b, int h, int dir, int sl, bool last, LAS unsigned char* L, int lane, unsigned* prog) {
    LAS unsigned char* vim = L + GL_VIM + sl * 4096; volatile LAS unsigned* flag = (volatile LAS unsigned*)(L + GL_FLAG);
    const int r = lane & 31, hh = lane >> 5, rh = (lane >> 4) & 1, qq = (lane & 15) >> 2, p4 = lane & 3;
    const int vcol = ZC_GV + h * 128 + 32 * sl;
    const int a_off = qq * GIM_STRIDE + (16 * rh + 4 * p4) * 2;
    const int v_off = qq * 64 + (16 * rh + 4 * p4) * 2;
    const __amdgpu_buffer_rsrc_t zrs = __builtin_amdgcn_make_buffer_rsrc((void*)Z, 0, (int)((size_t)MTOT * NZ * 2), 0x00020000);
    const __amdgpu_buffer_rsrc_t ors = __builtin_amdgcn_make_buffer_rsrc((void*)(OG + (size_t)dir * MTOT * 512), 0, MTOT * 512 * 2, 0x00020000);
    const int vo16 = (dir ? 15 - (lane >> 2) : (lane >> 2)) * (NZ * 2) + (lane & 3) * 16;
    const int voo2 = (dir ? 31 - 16 * rh - (lane & 15) : 16 * rh + (lane & 15)) * 1024 + (h * 128 + 32 * sl + 16 * hh) * 2;
    f32x16 S[2];
#pragma unroll
    for (int i = 0; i < 16; ++i) { S[0][i] = 0.f; S[1][i] = 0.f; }
    v4u vld[4];
#define GLA_LOAD_V(cc) do { bool ic_; int rb_; gla_chunk_rows((cc), b, dir, ic_, rb_); _Pragma("unroll") for (int i = 0; i < 4; ++i) \
        vld[i] = __builtin_amdgcn_raw_buffer_load_b128(zrs, vo16, (dir ? rb_ - 16 * i - 15 : rb_ + 16 * i) * (NZ * 2) + vcol * 2, 0); } while (0)
    GLA_LOAD_V(0);
    for (int c = 0; c < 36; ++c) {
        bool isctx; int rbase; gla_chunk_rows(c, b, dir, isctx, rbase);
#pragma unroll
        for (int i = 0; i < 4; ++i) *(LAS v4u*)(vim + (16 * i + (lane >> 2)) * 64 + (lane & 3) * 16) = vld[i];
        if (c + 1 < 36) GLA_LOAD_V(c + 1);
        bf16x8 vf[2][2];
#pragma unroll
        for (int jt = 0; jt < 2; ++jt)
#pragma unroll
            for (int s = 0; s < 2; ++s) { const LAS unsigned char* p = vim + (32 * jt + 16 * s + 4 * hh) * 64 + v_off; vf[jt][s] = mk8(trr(p), trr(p + 8 * 64)); }
        const int bsel = c & 1; const LAS unsigned char* sb = L + GL_SB + bsel * GL_SBSZ;
        { unsigned spins = 0; while (lds_ld(flag + 12 + bsel) < (unsigned)(c + 1) && ++spins <= GL_SPIN_CAP) __builtin_amdgcn_s_sleep(2); }
        asm volatile("" ::: "memory");
        const LAS float* evec = (const LAS float*)(sb + GL_EV);
#pragma unroll
        for (int dt = 0; dt < 2; ++dt)
#pragma unroll
            for (int g = 0; g < 4; ++g) { const f32x4 e4 = *(const LAS f32x4*)(evec + 32 * dt + 8 * g + 4 * hh);
#pragma unroll
                for (int e = 0; e < 4; ++e) S[dt][4 * g + e] *= e4[e]; }
        bf16x8 sf[2][2];
#pragma unroll
        for (int dt = 0; dt < 2; ++dt) { sf[dt][0] = pack8(S[dt], 0); sf[dt][1] = pack8(S[dt], 1); }
#pragma unroll
        for (int it = 0; it < 2; ++it) {
            f32x16 acc;
#pragma unroll
            for (int i = 0; i < 16; ++i) acc[i] = 0.f;
#pragma unroll
            for (int dt = 0; dt < 2; ++dt)
#pragma unroll
                for (int s = 0; s < 2; ++s) acc = MFMA32(*(const LAS bf16x8*)(sb + GL_QF + ((it * 2 + dt) * 2 + s) * 1024 + lane * 16), sf[dt][s], acc);
#pragma unroll
            for (int jt = 0; jt <= it; ++jt) {
                const LAS unsigned char* xp = sb + GL_XF + (it + jt) * 2048 + lane * 16;
                acc = MFMA32(*(const LAS bf16x8*)xp, vf[jt][0], acc); acc = MFMA32(*(const LAS bf16x8*)(xp + 1024), vf[jt][1], acc);
            }
            if (!(isctx && last)) {
#pragma unroll
                for (int g = 0; g < 4; ++g) *(LAS v2u*)(vim + r * 64 + 8 * (2 * g + hh)) = (v2u){cvtpk(acc[4 * g], acc[4 * g + 1]), cvtpk(acc[4 * g + 2], acc[4 * g + 3])};
                const int ph = rh, dh = hh;
                v2u t4[4];
#pragma unroll
                for (int a = 0; a < 4; ++a) t4[a] = __builtin_bit_cast(v2u, trr(vim + (16 * dh + 4 * a + qq) * 64 + 32 * ph + 8 * p4));
                const int so = (dir ? rbase - 32 * it - 31 : rbase + 32 * it) * 1024;
                __builtin_amdgcn_raw_buffer_store_b128((v4u){t4[0].x, t4[0].y, t4[1].x, t4[1].y}, ors, voo2, so, 16);
                __builtin_amdgcn_raw_buffer_store_b128((v4u){t4[2].x, t4[2].y, t4[3].x, t4[3].y}, ors, voo2 + 16, so, 16);
            }
        }
#pragma unroll
        for (int dt = 0; dt < 2; ++dt) {
#pragma unroll
            for (int jt = 0; jt < 2; ++jt)
#pragma unroll
                for (int s = 0; s < 2; ++s) { const LAS unsigned char* p = sb + GL_KIM + (32 * jt + 16 * s + 4 * hh) * GIM_STRIDE + dt * 64 + a_off; S[dt] = MFMA32(mk8(trr(p), trr(p + 8 * GIM_STRIDE)), vf[jt][s], S[dt]); }
#pragma unroll
            for (int g = 0; g < 4; ++g) { const f32x4 e4 = *(const LAS f32x4*)(evec + 64 + 32 * dt + 8 * g + 4 * hh);
#pragma unroll
                for (int e = 0; e < 4; ++e) S[dt][4 * g + e] *= e4[e]; }
        }
        asm volatile("s_waitcnt lgkmcnt(0)" ::: "memory");
        if (lane == 0) flag[4 + 4 * bsel + sl] = (unsigned)(c + 1);
        asm volatile("" ::: "memory");
        asm volatile("s_waitcnt vmcnt(4)" ::: "memory");
        if (c > 0 && lane == 0) __hip_atomic_store(prog + sl, (unsigned)c, __ATOMIC_RELAXED, __HIP_MEMORY_SCOPE_AGENT);
        asm volatile("" ::: "memory");
    }
    asm volatile("s_waitcnt vmcnt(0)" ::: "memory");
    if (lane == 0) __hip_atomic_store(prog + sl, 36u, __ATOMIC_RELAXED, __HIP_MEMORY_SCOPE_AGENT);
#undef GLA_LOAD_V
}
__device__ __forceinline__ void gla_xwave(LAS unsigned char* L, int lane) {
    volatile LAS unsigned* flag = (volatile LAS unsigned*)(L + GL_FLAG);
    const int r = lane & 31, hh = lane >> 5;
    for (int c = 0; c < 36; ++c) {
        const int bsel = c & 1; LAS unsigned char* sb = L + GL_SB + bsel * GL_SBSZ;
        { unsigned spins = 0; while ((lds_ld(flag + 2 * bsel) < (unsigned)(c + 1) || lds_ld(flag + 2 * bsel + 1) < (unsigned)(c + 1)) && ++spins <= GL_SPIN_CAP) __builtin_amdgcn_s_sleep(2); }
        asm volatile("" ::: "memory");
#pragma unroll
        for (int t = 0; t < 3; ++t) {
            const int jt = t >> 1, it = (t + 1) >> 1;
            f32x16 x;
#pragma unroll
            for (int i = 0; i < 16; ++i) x[i] = 0.f;
#pragma unroll
            for (int dt = 0; dt < 2; ++dt)
#pragma unroll
                for (int s = 0; s < 2; ++s) x = MFMA32(*(const LAS bf16x8*)(sb + GL_KF + ((jt * 2 + dt) * 2 + s) * 1024 + lane * 16), *(const LAS bf16x8*)(sb + GL_QF + ((it * 2 + dt) * 2 + s) * 1024 + lane * 16), x);
            if (jt == it) {
#pragma unroll
                for (int i = 0; i < 16; ++i) { const int jrow = (i & 3) + 8 * (i >> 2) + 4 * hh; x[i] = (jrow <= r) ? x[i] : 0.f; }
            }
            *(LAS bf16x8*)(sb + GL_XF + t * 2048 + lane * 16) = pack8(x, 0); *(LAS bf16x8*)(sb + GL_XF + t * 2048 + 1024 + lane * 16) = pack8(x, 1);
        }
        asm volatile("s_waitcnt lgkmcnt(0)" ::: "memory");
        if (lane == 0) flag[12 + bsel] = (unsigned)(c + 1);
        asm volatile("" ::: "memory");
    }
}

typedef const float* __attribute__((address_space(4))) const* karg_tab_t;
#define KIN(i) (F.karg[(i)])
#define KOUT() ((float*)(F.karg[20]))
struct Frame {
    LAS unsigned char* lds;
    int tid, lane, wave, vcu, G, bx;
    unsigned char* ws; karg_tab_t karg;
};
enum { I_X = 0, I_C, I_CTX, I_CCTX, I_WMOD, I_BMOD, I_N1G, I_N2G, I_WIN, I_RPB, I_SINK, I_GATEW, I_GATEB, I_GNORM, I_WOUT, I_WUP, I_CONVW, I_CONVB, I_WDN, I_FNG };

template <bool WT = false> __device__ __forceinline__ void gemv64_item(Frame& F, const float* vp, int vstride, const float* vp8, bool do_silu, const float* W, int ldw, int col0, float* out, int ostride, const float* addb) {
    LAS float* tab = (LAS float*)F.lds; LAS float* red = (LAS float*)(F.lds + 36864);
    __syncthreads();
#pragma unroll 1
    for (int hb = 0; hb < 2; ++hb) {
        float tv[9];
#pragma unroll
        for (int j = 0; j < 9; ++j) { const int i = F.tid + NTHREADS * (9 * hb + j), s = i >> 10, k = i & 1023; tv[j] = (s < 8) ? vp[(size_t)s * vstride + k] : vp8[k]; }
#pragma unroll
        for (int j = 0; j < 9; ++j) { float v = tv[j]; if (do_silu) v = v / (1.0f + expf(-v)); tab[F.tid + NTHREADS * (9 * hb + j)] = v; }
    }
    __syncthreads();
    const int rq = F.lane >> 4, cq = F.lane & 15;
    f32x4 acc[9];
#pragma unroll
    for (int s = 0; s < 9; ++s) acc[s] = (f32x4){0.f, 0.f, 0.f, 0.f};
    const float* wp = W + (size_t)(F.wave * 128 + rq) * ldw + col0 + 4 * cq;
    const LAS float* tp = tab + F.wave * 128 + rq;
#pragma unroll 1
    for (int k0 = 0; k0 < 128; k0 += 64) {
        f32x4 wv[16];
#pragma unroll
        for (int u = 0; u < 16; ++u) wv[u] = *(const f32x4*)(wp + (size_t)(k0 + 4 * u) * ldw);
#pragma unroll
        for (int u = 0; u < 16; ++u)
#pragma unroll
            for (int s = 0; s < 9; ++s) acc[s] += wv[u] * tp[s * 1024 + k0 + 4 * u]; }
#pragma unroll
    for (int s = 0; s < 9; ++s)
#pragma unroll
        for (int e = 0; e < 4; ++e) acc[s][e] = xsum_16_32(acc[s][e]);
    if (rq == 0) {
#pragma unroll
        for (int s = 0; s < 9; ++s) *(LAS f32x4*)(red + (F.wave * 9 + s) * 64 + 4 * cq) = acc[s];
    }
    __syncthreads();
    for (int i = F.tid; i < 576; i += NTHREADS) { const int s = i >> 6, n = i & 63; float t = 0.f;
#pragma unroll
        for (int w = 0; w < 8; ++w) t += red[(w * 9 + s) * 64 + n];
        if (addb) t += addb[col0 + n];
        if constexpr (WT) __hip_atomic_store(out + (size_t)s * ostride + col0 + n, t, __ATOMIC_RELAXED, __HIP_MEMORY_SCOPE_AGENT);
        else out[(size_t)s * ostride + col0 + n] = t; }
}
__device__ __forceinline__ int in_rowmap(int c) { if (c < 768 || c >= 1152) return c; const int hb = c & ~63, d = c & 63; return hb + ((d & 31) >> 2) * 8 + ((d >> 5) << 2) + (d & 3); }
__device__ __forceinline__ int up_rowmap(int c) { const int gate = c >= FFD ? 1 : 0, f = c - gate * FFD; return ((f >> 7) << 8) + (gate << 7) + (f & 127); }
template <int MAP> __device__ __forceinline__ void transpose_item(const float* W, int ldw, int nblk, bf16* WT, int K, int row_off, LAS float* scr, int item, int lane) {
    const int kb = item / nblk, nb = item % nblk, k0 = 64 * kb, n0 = 32 * nb;
    f32x4 ld[8];
#pragma unroll
    for (int j = 0; j < 8; ++j) ld[j] = *(const f32x4*)(W + (size_t)(k0 + 8 * j + (lane >> 3)) * ldw + n0 + 4 * (lane & 7));
#pragma unroll
    for (int j = 0; j < 8; ++j) { LAS float* d = scr + (8 * j + (lane >> 3)) * 33 + 4 * (lane & 7); d[0] = ld[j][0]; d[1] = ld[j][1]; d[2] = ld[j][2]; d[3] = ld[j][3]; }
    LDS_WAIT(); asm volatile("" ::: "memory");
    const int c = lane & 7;
#pragma unroll
    for (int j = 0; j < 4; ++j) { const int n = (lane >> 3) + 8 * j; const LAS float* s = scr + (8 * c) * 33 + n;
        v4u o; o.x = pk2(s[0 * 33], s[1 * 33]); o.y = pk2(s[2 * 33], s[3 * 33]); o.z = pk2(s[4 * 33], s[5 * 33]); o.w = pk2(s[6 * 33], s[7 * 33]);
        *(v4u*)(WT + (size_t)(row_off + (MAP == 1 ? in_rowmap(n0 + n) : (MAP == 2 ? up_rowmap(n0 + n) : n0 + n))) * K + k0 + 8 * c) = o; }
    LDS_WAIT(); asm volatile("" ::: "memory");
}

constexpr int CV_IN = 16 * 88, CV_OUT = 16 * 32, CV_UP = 16 * 176, CV_DN = 44 * 32, CV_ALL = CV_IN + CV_OUT + CV_UP + CV_DN;
__device__ __forceinline__ void convert_range(Frame& F, int l, int lo, int hi, int gw, int ngw) {
    LAS float* scr = (LAS float*)(F.lds + 57344 + F.wave * 8448);
    for (int it = lo + gw; it < hi; it += ngw) {
        int r = it;
        if (r < CV_IN) { transpose_item<1>(KIN(I_WIN) + (size_t)l * 1024 * NINSRC, NINSRC, 88, (bf16*)(F.ws + WS_WIN) + (size_t)l * NZ * 1024, 1024, 0, scr, r, F.lane); continue; } r -= CV_IN;
        if (r < CV_OUT) { transpose_item<0>(KIN(I_WOUT) + (size_t)l * 1024 * 1024, 1024, 32, (bf16*)(F.ws + WS_WOUT) + (size_t)l * 1024 * 1024, 1024, 0, scr, r, F.lane); continue; } r -= CV_OUT;
        if (r < CV_UP) { transpose_item<2>(KIN(I_WUP) + (size_t)l * 1024 * NUP, NUP, 176, (bf16*)(F.ws + WS_WUP) + (size_t)l * NUP * 1024, 1024, 0, scr, r, F.lane); continue; } r -= CV_UP;
        transpose_item<0>(KIN(I_WDN) + (size_t)l * FFD * 1024, 1024, 32, (bf16*)(F.ws + WS_WDN) + (size_t)l * 1024 * FFD, FFD, 0, scr, r, F.lane);
    }
}
__device__ __forceinline__ void gate_fold(Frame& F, int l, int t0, int nt);
__device__ __forceinline__ void phase_p0a(Frame& F) {
    float* mod = (float*)(F.ws + WS_MOD);
    for (int it = F.vcu; it < 2 * 96; it += F.G) {
        const int l = it / 96, cg = it % 96;
        gemv64_item<true>(F, KIN(I_C), 1024, KIN(I_CCTX), true, KIN(I_WMOD) + (size_t)l * 1024 * MODW, MODW, cg * 64, mod + (size_t)l * NSEG * MODW, MODW, KIN(I_BMOD) + (size_t)l * MODW);
        asm volatile("s_waitcnt vmcnt(0)" ::: "memory"); __syncthreads();
        if (l == 0 && F.tid == 0) (void)__hip_atomic_fetch_add((unsigned*)(F.ws + WS_CTL) + CW_UPC, 1u, __ATOMIC_RELAXED, __HIP_MEMORY_SCOPE_AGENT);
    }
    __syncthreads();
    convert_range(F, 0, 0, CV_IN + CV_OUT, F.vcu * NWAVES + F.wave, F.G * NWAVES);
    { float* cosT = (float*)(F.ws + WS_ROPE); float* sinT = cosT + 2048 * 32;
      for (int idx = F.vcu * NTHREADS + F.tid; idx < 2048 * 32; idx += F.G * NTHREADS) { const int t = idx >> 5, d = idx & 31, f = d & 15; const float pos = (d < 16) ? (float)(t >> 6) : (float)(t & 63);
          const float inv = powf(10000.0f, -(float)f / 16.0f); const float ang = pos * inv; cosT[idx] = cosf(ang); sinT[idx] = sinf(ang); } }
    gate_fold(F, 0, F.vcu * NTHREADS + F.tid, F.G * NTHREADS);
}
__device__ __forceinline__ void gate_fold(Frame& F, int l, int t0, int nt) {
    for (int idx = t0; idx < 2 * 256 * 128; idx += nt) {
        const int n = idx & 255, kg = (idx >> 8) & 127, dir = (idx >> 15) & 1;
        const float* wi = KIN(I_WIN) + (size_t)l * 1024 * NINSRC + (size_t)(kg * 8) * NINSRC + 2816 + 16 * dir;
        const float* gw_ = KIN(I_GATEW) + (size_t)((l * 2 + dir) * 16) * 256 + n;
        float g[16];
#pragma unroll
        for (int j = 0; j < 16; ++j) g[j] = gw_[j * 256];
        float r[8];
#pragma unroll
        for (int kk = 0; kk < 8; ++kk) { const f32x4* wr4 = (const f32x4*)(wi + (size_t)kk * NINSRC); float a = 0.f;
#pragma unroll
            for (int q = 0; q < 4; ++q) { const f32x4 w4 = wr4[q]; a += w4[0] * g[4 * q] + w4[1] * g[4 * q + 1] + w4[2] * g[4 * q + 2] + w4[3] * g[4 * q + 3]; }
            r[kk] = a; }
        v4u o; o.x = pk2(r[0], r[1]); o.y = pk2(r[2], r[3]); o.z = pk2(r[4], r[5]); o.w = pk2(r[6], r[7]);
        *(v4u*)((bf16*)(F.ws + WS_WIN) + (size_t)l * NZ * 1024 + (size_t)(2816 + 256 * dir + n) * 1024 + kg * 8) = o;
    }
}

__device__ __forceinline__ void bias_items(Frame& F, int lo, int hi, int blk, int nblk) {
    const float* mod = (const float*)(F.ws + WS_MOD);
    float* bin = (float*)(F.ws + WS_BIN); float* bup = (float*)(F.ws + WS_BUP);
    for (int it = lo + blk; it < hi; it += nblk) {
        int l, r;
        if (it < 44) { l = 0; r = it; } else if (it < 46) { l = 0; r = 132 + (it - 44); } else if (it < 134) { l = 0; r = 44 + (it - 46); } else { l = 1; r = it - 134; }
        const float* modl = mod + (size_t)l * NSEG * MODW;
        if (r < 44) { gemv64_item(F, modl + 0, MODW, modl + 8 * MODW + 0, false, KIN(I_WIN) + (size_t)l * 1024 * NINSRC, NINSRC, r * 64, bin + (size_t)l * NSEG * NZ, NZ, nullptr); continue; } r -= 44;
        if (r < 88) { gemv64_item(F, modl + 3072, MODW, modl + 8 * MODW + 3072, false, KIN(I_WUP) + (size_t)l * 1024 * NUP, NUP, r * 64, bup + (size_t)l * NSEG * NUP, NUP, nullptr); continue; } r -= 88;
        {
            const int dir = r;
            LAS float* part = (LAS float*)F.lds;
            LAS float* T = (LAS float*)(F.lds + 4096);
            __syncthreads();
            {
                const int j = F.tid & 15, ks = F.tid >> 4;
                const float* wi = KIN(I_WIN) + (size_t)l * 1024 * NINSRC + (size_t)(ks * 32) * NINSRC + 2816 + 16 * dir + j;
                float wv[32];
#pragma unroll
                for (int u = 0; u < 32; ++u) wv[u] = wi[(size_t)u * NINSRC];
                float acc[9];
#pragma unroll
                for (int s = 0; s < 9; ++s) { const float* sh = modl + (size_t)s * MODW + ks * 32; float a = 0.f;
#pragma unroll
                    for (int u = 0; u < 32; ++u) a += sh[u] * wv[u];
                    acc[s] = a; }
                LAS float* part2 = (LAS float*)(F.lds + 8192);
#pragma unroll
                for (int s = 0; s < 9; ++s) part2[ks * 144 + s * 16 + j] = acc[s];
            }
            __syncthreads();
            if (F.tid < 144) { const LAS float* part2 = (const LAS float*)(F.lds + 8192); float t = 0.f;
#pragma unroll
                for (int ks = 0; ks < 32; ++ks) t += part2[ks * 144 + F.tid];
                T[F.tid] = t; }
            __syncthreads();
            for (int i = F.tid; i < 9 * 256; i += NTHREADS) { const int s = i >> 8, n = i & 255;
                const float* gw_ = KIN(I_GATEW) + (size_t)((l * 2 + dir) * 16) * 256 + n; float a = KIN(I_GATEB)[(l * 2 + dir) * 256 + n];
#pragma unroll
                for (int j = 0; j < 16; ++j) a += T[s * 16 + j] * gw_[j * 256];
                bin[(size_t)l * NSEG * NZ + (size_t)s * NZ + 2816 + 256 * dir + n] = a; }
        }
    }
}
__device__ __forceinline__ void phase_p0b(Frame& F) {
    const float* mod = (const float*)(F.ws + WS_MOD);
    cnt_wait((unsigned*)(F.ws + WS_CTL) + CW_UPC, 96u, F.tid);
    bias_items(F, 0, 46, F.vcu, F.G);
    const int gw = F.vcu * NWAVES + F.wave, NGW = F.G * NWAVES;
    bf16* XM = (bf16*)(F.ws + WS_XM); float* ssq = (float*)(F.ws + WS_SSQB);
    const int ngrp = MTOT / 4, nfirst = 2 * NGW < ngrp ? 2 * NGW : ngrp; const int gw2 = (F.vcu - 46) * NWAVES + F.wave, NGW2 = (F.G - 46) * NWAVES;
    const float* g1 = KIN(I_N1G);
#define XM1_LOAD(xv, grp_) do { const int row0_ = (grp_) * 4; _Pragma("unroll") for (int u = 0; u < 4; ++u) { const int row = row0_ + u; const float* src = row < MLAT ? KIN(I_X) + (size_t)row * 1024 : KIN(I_CTX) + (size_t)(row - MLAT) * 1024; \
        _Pragma("unroll") for (int j = 0; j < 4; ++j) xv[u][j] = *(const f32x4*)(src + 8 * (F.lane + 64 * (j >> 1)) + 4 * (j & 1)); } } while (0)
#define XM1_DO(xv, grp_) do { const int row0_ = (grp_) * 4; const float* sc1 = mod + (size_t)pg8::seg_of(row0_) * MODW + 1024; f32x4 gm[4]; \
        _Pragma("unroll") for (int j = 0; j < 4; ++j) { const int k = 8 * (F.lane + 64 * (j >> 1)) + 4 * (j & 1); gm[j] = *(const f32x4*)(g1 + k) * (*(const f32x4*)(sc1 + k) + 1.0f); } \
        _Pragma("unroll") for (int u = 0; u < 4; ++u) { const int row = row0_ + u; float ss = 0.f; \
            _Pragma("unroll") for (int jj = 0; jj < 2; ++jj) { const int k = 8 * (F.lane + 64 * jj); const f32x4 x0 = xv[u][2 * jj], x1 = xv[u][2 * jj + 1]; \
                ss += ((x0[0] * x0[0] + x0[1] * x0[1]) + (x0[2] * x0[2] + x0[3] * x0[3])) + ((x1[0] * x1[0] + x1[1] * x1[1]) + (x1[2] * x1[2] + x1[3] * x1[3])); \
                const f32x4 m0 = x0 * gm[2 * jj], m1 = x1 * gm[2 * jj + 1]; \
                *(v4u*)(XM + (size_t)row * 1024 + k) = (v4u){pk2(m0[0], m0[1]), pk2(m0[2], m0[3]), pk2(m1[0], m1[1]), pk2(m1[2], m1[3])}; } \
            ss = wave_sum(ss, F.lane); \
            if (F.lane == 0) ssq[row] = ss; } } while (0)
    const int grp0 = gw, grp1 = gw + NGW, grp2 = (F.vcu >= 46) ? nfirst + gw2 : ngrp;
    const bool h0 = grp0 < nfirst, h1 = grp1 < nfirst, h2 = grp2 < ngrp;
    f32x4 xa[4][4], xb[4][4];
    if (h0) XM1_LOAD(xa, grp0);
    if (h1) XM1_LOAD(xb, grp1);
    asm volatile("" ::: "memory");
    if (h0) XM1_DO(xa, grp0);
    asm volatile("" ::: "memory");
    if (h2) XM1_LOAD(xa, grp2);
    asm volatile("" ::: "memory");
    if (h1) XM1_DO(xb, grp1);
    if (h2) XM1_DO(xa, grp2);
#undef XM1_LOAD
#undef XM1_DO
}

__device__ __forceinline__ void phase_mixer(Frame& F, int l, bool last) {
    const bf16* Z = (const bf16*)(F.ws + WS_Z); bf16* Y = (bf16*)(F.ws + WS_Y); bf16* OG = (bf16*)(F.ws + WS_XM);
    constexpr int RPB_OFF = 136960;
    LAS float* rpbL = (LAS float*)(F.lds + RPB_OFF);
    if ((F.vcu & 31) >= 8) {
      const float* rpb = KIN(I_RPB) + (size_t)l * 4 * 15 * 31; float rv[4];
#pragma unroll
      for (int j = 0; j < 4; ++j) { const int i = F.tid + NTHREADS * j, rw = i >> 5, cl = i & 31; rv[j] = (i < 4 * 15 * 32 && cl < 31) ? rpb[rw * 31 + cl] : 0.f; }
#pragma unroll
      for (int j = 0; j < 4; ++j) { const int i = F.tid + NTHREADS * j, cl = i & 31; if (i < 4 * 15 * 32) rpbL[i] = (cl < 31) ? rv[j] * LOG2E : -INFINITY; } }
    if (F.tid < 64) ((LAS unsigned*)(F.lds + GL_FLAG))[F.tid] = 0u;
    __syncthreads();
    const int xg = F.vcu >> 5, xl = F.vcu & 31;
    const bool glawg = xl < 8;
    if (glawg && F.wave < 7) {
        const int b = xg, h = xl >> 1, dir = xl & 1;
        if (F.wave < 4) { __builtin_amdgcn_s_setprio(3); gla_scan(Z, OG, b, h, dir, F.wave, last, F.lds, F.lane, (unsigned*)(F.ws + WS_CTL) + CW_GLAP + ((l * 8 + b) * 8 + h * 2 + dir) * 32); }
        else if (F.wave == 6) { __builtin_amdgcn_s_setprio(2); gla_xwave(F.lds, F.lane); }
        else { __builtin_amdgcn_s_setprio(1); if (F.wave == 4) gla_prep(Z, b, h, dir, 0, F.lds, F.lane); else gla_prep(Z, b, h, dir, 1, F.lds, F.lane); }
        __builtin_amdgcn_s_setprio(0);
        return;
    }
    if (glawg) return;
    const float* sink = KIN(I_SINK) + l * 4;
    const int nblk = last ? 16 : 18;
    unsigned* qctr = (unsigned*)(F.ws + WS_CTL) + CW_QUEUE + (l * 8 + xg) * 64;
    volatile LAS int* itw = (volatile LAS int*)(F.lds + AT_RING);
    int nxt_a = 0;
    if (F.tid == 0) nxt_a = (int)__hip_atomic_fetch_add(qctr, 1u, __ATOMIC_RELAXED, __HIP_MEMORY_SCOPE_AGENT);
    for (;;) {
        if (F.tid == 0) *itw = nxt_a;
        asm volatile("s_waitcnt lgkmcnt(0)" ::: "memory"); __builtin_amdgcn_s_barrier(); asm volatile("" ::: "memory");
        const int it = __builtin_amdgcn_readfirstlane(*itw);
        if (it >= nblk * 6) break;
        if (F.tid == 0) nxt_a = (int)__hip_atomic_fetch_add(qctr, 1u, __ATOMIC_RELAXED, __HIP_MEMORY_SCOPE_AGENT);
        if (it < nblk * 2) wa_block(Z, Y, sink, F.lds, F.lane, F.wave, xg, it >> 1, it & 1);
        else { const int k = it - nblk * 2; na_block(Z, Y, rpbL, F.lds, F.lane, F.wave, xg, k >> 2, k & 3); }
    }
    {
        const float* gnorm = KIN(I_GNORM) + l * 128; const int lane = F.lane; const float gn0 = gnorm[2 * lane], gn1 = gnorm[2 * lane + 1];
        unsigned* fq = (unsigned*)(F.ws + WS_CTL) + CW_FQ + (l * 8 + xg) * 16;
        unsigned* gp = (unsigned*)(F.ws + WS_CTL) + CW_GLAP + (l * 8 + xg) * 256;
        const int nit = last ? 128 : 144;
        int nxt_v = 0;
        if (F.tid == 0) nxt_v = (int)__hip_atomic_fetch_add(fq, 1u, __ATOMIC_RELAXED, __HIP_MEMORY_SCOPE_AGENT);
        for (;;) {
            if (F.tid == 0) *itw = nxt_v;
            asm volatile("s_waitcnt lgkmcnt(0)" ::: "memory"); __builtin_amdgcn_s_barrier(); asm volatile("" ::: "memory");
            const int it = __builtin_amdgcn_readfirstlane(*itw);
            if (it >= nit) break;
            if (F.tid == 0) nxt_v = (int)__hip_atomic_fetch_add(fq, 1u, __ATOMIC_RELAXED, __HIP_MEMORY_SCOPE_AGENT);
            const int j = (it >> 2) + (last ? 4 : 0), h = it & 3;
            int cf, cb, rowbase;
            if (j < 4) { cf = j; cb = 3 - j; rowbase = MLAT + xg * 256 + 64 * j; }
            else { const int t = j - 4; const int ci = (t & 1) ? 16 + (t >> 1) : 15 - (t >> 1); cf = 4 + ci; cb = 35 - ci; rowbase = xg * 2048 + ci * 64; }
            const int r0 = rowbase + 8 * F.wave;
            unsigned wg[8];
#pragma unroll
            for (int u = 0; u < 8; ++u) wg[u] = *(const unsigned*)(Z + (size_t)(r0 + u) * NZ + ZC_GO + h * 128 + 2 * lane);
            if (F.wave == 0) {
                const int pd = (lane >> 2) & 1; unsigned* pp = gp + (h * 2 + pd) * 32 + (lane & 3); const unsigned need = (unsigned)((pd ? cb : cf) + 1); unsigned sp = 0u;
                for (;;) {
                    const unsigned v = __hip_atomic_load(pp, __ATOMIC_RELAXED, __HIP_MEMORY_SCOPE_AGENT);
                    if (__builtin_amdgcn_ballot_w64(v >= need) == ~0ull || ++sp > (1u << 16)) break;
                    __builtin_amdgcn_s_sleep(8);
                }
            }
            asm volatile("s_waitcnt lgkmcnt(0)" ::: "memory"); __builtin_amdgcn_s_barrier(); asm volatile("" ::: "memory");
            unsigned wf[8], wb[8];
#pragma unroll
            for (int u = 0; u < 8; ++u) { const size_t row = (size_t)(r0 + u);
                wf[u] = __hip_atomic_load((unsigned*)(OG + row * 512 + h * 128 + 2 * lane), __ATOMIC_RELAXED, __HIP_MEMORY_SCOPE_AGENT);
                wb[u] = __hip_atomic_load((unsigned*)(OG + (size_t)MTOT * 512 + row * 512 + h * 128 + 2 * lane), __ATOMIC_RELAXED, __HIP_MEMORY_SCOPE_AGENT); }
#pragma unroll
            for (int u = 0; u < 8; ++u) {
                const float x0 = bflo(wf[u]) + bflo(wb[u]), x1 = bfhi(wf[u]) + bfhi(wb[u]);
                const float ss = wave_sum(x0 * x0 + x1 * x1, lane); const float ri = 1.0f / sqrtf(ss * (1.0f / 128.0f) + 1e-6f);
                const float g0 = bflo(wg[u]), g1 = bfhi(wg[u]);
                const float y0 = x0 * ri * gn0 * (g0 / (1.0f + expf(-g0))), y1 = x1 * ri * gn1 * (g1 / (1.0f + expf(-g1)));
                *(unsigned*)(Y + (size_t)(r0 + u) * 1024 + 512 + h * 128 + 2 * lane) = pk2(y0, y1);
            }
        }
    }
}

struct Args { const float* in[20]; float* out; unsigned char* ws; int pad0, pad1; };
template <int PT> __device__ __forceinline__ void run_phase(int wave_id, LAS unsigned char* lds0, int l) {
    Frame F;
    { karg_tab_t kp = (karg_tab_t)__builtin_amdgcn_kernarg_segment_ptr(); asm volatile("; launder karg, phase %1" : "+s"(kp) : "i"(PT)); F.karg = kp; }
    { int w = wave_id; asm volatile("; launder wave, phase %1" : "+s"(w) : "i"(PT)); F.wave = w; }
    { unsigned ones = ~0u; asm volatile("; launder lane, phase %1" : "+s"(ones) : "i"(PT)); F.lane = __builtin_amdgcn_mbcnt_hi(ones, __builtin_amdgcn_mbcnt_lo(ones, 0u)); }
    F.tid = F.wave * 64 + F.lane;
    { int gx = gridDim.x, bx = blockIdx.x; asm volatile("; launder grid, phase %2" : "+s"(gx), "+s"(bx) : "i"(PT)); F.G = gx; F.bx = bx; F.vcu = (gx % 8 == 0) ? (bx % 8) * (gx / 8) + bx / 8 : bx; }
    F.ws = (unsigned char*)F.karg[21];
    { LAS unsigned char* lp = lds0; asm volatile("; launder lds, phase %1" : "+s"(lp) : "i"(PT)); F.lds = lp; }
    const bool last = (l == DEPTH - 1);
    float* modl = (float*)(F.ws + WS_MOD) + (size_t)l * NSEG * MODW;
    if constexpr (PT == 0) phase_p0a(F);
    else if constexpr (PT == 1) phase_p0b(F);
    else if constexpr (PT == 2) {
        pg8::EpiIn E{(pg8::bf16_t*)(F.ws + WS_Z), (const float*)(F.ws + WS_SSQB), (const float*)(F.ws + WS_BIN) + (size_t)l * NSEG * NZ, (const float*)(F.ws + WS_ROPE), 0};
        if (!last) {
            pg8::Gemm g{(const pg8::bf16_t*)(F.ws + WS_XM), (const pg8::bf16_t*)(F.ws + WS_WIN) + (size_t)l * NZ * 1024, MTOT, NZ, 1024, 256};
            pg8::StaticOrder S; S.init(MTOT, NZ, F.G, F.bx);
            pg8::gemm_phase<pg8::EpiIn, pg8::StaticOrder, true, true>(F.lds, g, S, E, F.tid);
        } else {
            pg8::Gemm g{(const pg8::bf16_t*)(F.ws + WS_XM), (const pg8::bf16_t*)(F.ws + WS_WIN) + (size_t)l * NZ * 1024, MLAT, NZ, 1024, 256};
            pg8::StaticOrder S; S.init(MLAT, NZ, F.G, F.bx);
            {
                struct Full3 { pg8::StaticOrder s; int lim;
                    __device__ __forceinline__ bool next(int i, pg8::Unit& u) const { if ((long)i * s.G + s.c >= lim) return false; return s.next(i, u); }
                    __device__ __forceinline__ void a_ready(const pg8::Unit&) const {} __device__ __forceinline__ void done(const pg8::Unit&) const {} };
                Full3 SF{S, (S.nwg / F.G) * F.G};
                pg8::gemm_phase<pg8::EpiIn, Full3, true, true>(F.lds, g, SF, E, F.tid);
            }
            {
                const int nfull = (S.nwg / F.G) * F.G, nrem = S.nwg - nfull, hu = F.bx >> 1, hm = F.bx & 1;
                pg8::Unit u; bool have = false;
                if (hu < nrem) { pg8::StaticOrder s1 = S; s1.c = nfull + hu; s1.G = 1 << 20; have = s1.next(0, u); }
                else if (hu - nrem < 64) { const int r = hu - nrem; const int cc = r & 7; u.pm = MLAT / 256 + (r >> 3); u.pn = cc == 0 ? 1 : cc == 1 ? 2 : cc == 2 ? 4 : cc == 3 ? 6 : cc == 4 ? 7 : cc == 5 ? 8 : cc == 6 ? 11 : 12; have = true; }
                if (have) {
                    pg8::EpiInT<true> E2{(pg8::bf16_t*)(F.ws + WS_Z), (const float*)(F.ws + WS_SSQB), (const float*)(F.ws + WS_BIN) + (size_t)l * NSEG * NZ, (const float*)(F.ws + WS_ROPE), 0};
                    pg8::Gemm g2{(const pg8::bf16_t*)(F.ws + WS_XM), (const pg8::bf16_t*)(F.ws + WS_WIN) + (size_t)l * NZ * 1024, MTOT, NZ, 1024, 128};
                    pg8::OneUnit O1; O1.u.pm = 2 * u.pm + hm; O1.u.pn = u.pn;
                    int tid_ = F.tid; asm volatile("; half-tile unit: lane constants re-derived" : "+v"(tid_));
                    pg8::gemm_phase<pg8::EpiInT<true>, pg8::OneUnit, true, true, true>(F.lds, g2, O1, E2, tid_);
                }
            }
        }
    } else if constexpr (PT == 4) phase_mixer(F, l, last);
    else if constexpr (PT == 5) {
        pg8::Gemm g{(const pg8::bf16_t*)(F.ws + WS_Y), (const pg8::bf16_t*)(F.ws + WS_WOUT) + (size_t)l * 1024 * 1024, MLAT, 1024, 1024, 256};
        pg8::StaticOrder S; S.init(MLAT, 1024, F.G, F.bx);
        pg8::bf16_t* XB = (pg8::bf16_t*)KOUT();
        if (l == 0) {
            pg8::EpiResT<true> E;
            E.xin_lat = KIN(I_X); E.xin_ctx = KIN(I_CTX); E.xbin = nullptr; E.xbout = XB;
            E.gt = modl + 2048; E.gn = KIN(I_N2G) + l * 1024; E.scn = modl + 4096;
            E.XM = (pg8::bf16_t*)(F.ws + WS_XM); E.ssq = (float*)(F.ws + WS_SSQA); E.row_base = 0;
            pg8::gemm_phase<pg8::EpiResT<true>, pg8::StaticOrder, true, true>(F.lds, g, S, E, F.tid);
            if (F.bx < 128) {
                pg8::EpiResT<true, true, true> E2;
                E2.xin_lat = KIN(I_X); E2.xin_ctx = KIN(I_CTX); E2.xbin = nullptr; E2.xbout = XB;
                E2.gt = modl + 2048; E2.gn = KIN(I_N2G) + l * 1024; E2.scn = modl + 4096;
                E2.XM = (pg8::bf16_t*)(F.ws + WS_XM); E2.ssq = (float*)(F.ws + WS_SSQA); E2.row_base = 0;
                pg8::Gemm g2{(const pg8::bf16_t*)(F.ws + WS_Y), (const pg8::bf16_t*)(F.ws + WS_WOUT) + (size_t)l * 1024 * 1024, MTOT, 1024, 1024, 128, 128};
                pg8::OneUnit O1; const int e = F.bx >> 2; O1.u.pm = 2 * (MLAT / 256 + (e >> 2)) + ((F.bx >> 1) & 1); O1.u.pn = 2 * (e & 3) + (F.bx & 1);
                int tid_ = F.tid; asm volatile("; quarter-tile unit: lane constants re-derived" : "+v"(tid_));
                pg8::gemm_phase<pg8::EpiResT<true, true, true>, pg8::OneUnit, true, true, true, true>(F.lds, g2, O1, E2, tid_);
            }
        } else {
            pg8::EpiResT<false> E;
            E.xin_lat = nullptr; E.xin_ctx = nullptr; E.xbin = XB; E.xbout = last ? (pg8::bf16_t*)(F.ws + WS_XB1) : XB;
            E.gt = modl + 2048; E.gn = KIN(I_N2G) + l * 1024; E.scn = modl + 4096;
            E.XM = (pg8::bf16_t*)(F.ws + WS_XM); E.ssq = (float*)(F.ws + WS_SSQA); E.row_base = 0;
            pg8::gemm_phase<pg8::EpiResT<false>, pg8::StaticOrder, true, true>(F.lds, g, S, E, F.tid);
        }
        { float* zb = (float*)(F.ws + WS_SSQB); for (int i = F.vcu * NTHREADS + F.tid; i < MTOT; i += F.G * NTHREADS) zb[i] = 0.f; }
        if (l == 0 && F.bx >= 128) { convert_range(F, 0, CV_IN + CV_OUT, CV_ALL, (F.bx - 128) * NWAVES + F.wave, (F.G - 128) * NWAVES); bias_items(F, 46, 134, F.bx - 128, F.G - 128); }
    } else if constexpr (PT == 6) {
        const int mvalid = last ? MLAT : MTOT; const int ntile = (mvalid + 253) / 254;
        pg8::Gemm g{(const pg8::bf16_t*)(F.ws + WS_XM) - 1024, (const pg8::bf16_t*)(F.ws + WS_WUP) + (size_t)l * NUP * 1024, ntile * 256, NUP, 1024, 254};
        pg8::EpiUpConv E{(pg8::bf16_t*)(F.ws + WS_Z), (const float*)(F.ws + WS_SSQA), (const float*)(F.ws + WS_BUP) + (size_t)l * NSEG * NUP, KIN(I_CONVW) + (size_t)l * 3 * FFD, KIN(I_CONVB) + (size_t)l * FFD, mvalid, 0};
        pg8::OneUnit O1;
        if (F.tid < 17) { unsigned z_; asm volatile("v_mov_b32 %0, 0" : "=v"(z_)); *(LAS v4u*)(F.lds + 131248 + F.tid * 16) = (v4u){z_, z_, z_, z_}; }
        if (last) {
            pg8::StaticOrder S; S.init(ntile * 256, NUP, F.G, F.bx);
#pragma unroll 1
            for (int i = 0; S.next(i, O1.u); ++i) { int tid_ = F.tid; asm volatile("; per-unit re-derivation of the K-loop's lane constants" : "+v"(tid_)); pg8::gemm_phase<pg8::EpiUpConv, pg8::OneUnit, false, true>(F.lds, g, O1, E, tid_); }
        } else {
            constexpr int NFULL = 69, RB = 254 * NFULL, NHALF = (MTOT - RB + 125) / 126;
            pg8::UpOrderH S; S.init(NFULL, NUP / 256, NHALF, F.G, F.bx);
            pg8::EpiUpConvT<true> E2{(pg8::bf16_t*)(F.ws + WS_Z), (const float*)(F.ws + WS_SSQA), (const float*)(F.ws + WS_BUP) + (size_t)l * NSEG * NUP, KIN(I_CONVW) + (size_t)l * 3 * FFD, KIN(I_CONVB) + (size_t)l * FFD, mvalid, RB};
            pg8::Gemm g2{(const pg8::bf16_t*)(F.ws + WS_XM) + (size_t)(RB - 1) * 1024, (const pg8::bf16_t*)(F.ws + WS_WUP) + (size_t)l * NUP * 1024, MTOT, NUP, 1024, 126};
#pragma unroll 1
            for (int i = 0; S.next(i, O1.u); ++i) { int tid_ = F.tid; asm volatile("; per-unit re-derivation of the K-loop's lane constants" : "+v"(tid_));
                if (O1.u.pm < 1000) pg8::gemm_phase<pg8::EpiUpConv, pg8::OneUnit, false, true>(F.lds, g, O1, E, tid_);
                else { O1.u.pm -= 1000; pg8::gemm_phase<pg8::EpiUpConvT<true>, pg8::OneUnit, false, true, true>(F.lds, g2, O1, E2, tid_); } }
        }
    } else if constexpr (PT == 8) {
        pg8::Gemm g{(const pg8::bf16_t*)(F.ws + WS_Z), (const pg8::bf16_t*)(F.ws + WS_WDN) + (size_t)l * 1024 * FFD, MLAT, 1024, FFD, 256};
        pg8::StaticOrder S; S.init(MLAT, 1024, F.G, F.bx);
        if (last) {
            pg8::EpiFinal EF{(const pg8::bf16_t*)(F.ws + WS_XB1), modl + 5120, KIN(I_FNG), KOUT(), (float*)(F.ws + WS_SSQB), (unsigned*)(F.ws + WS_CTL) + CW_FIN};
            pg8::gemm_phase<pg8::EpiFinal, pg8::StaticOrder, true, true>(F.lds, g, S, EF, F.tid);
            return;
        }
        pg8::EpiResT<false> E;
        E.xin_lat = nullptr; E.xin_ctx = nullptr; E.xbin = (const pg8::bf16_t*)KOUT(); E.xbout = last ? (pg8::bf16_t*)(F.ws + WS_XM) : (pg8::bf16_t*)KOUT();
        E.gt = modl + 5120;
        if (!last) { E.gn = KIN(I_N1G) + (l + 1) * 1024; E.scn = modl + NSEG * MODW + 1024; } else { E.gn = nullptr; E.scn = nullptr; }
        E.XM = (pg8::bf16_t*)(F.ws + WS_XM); E.ssq = (float*)(F.ws + WS_SSQB); E.row_base = 0;
        pg8::gemm_phase<pg8::EpiResT<false>, pg8::StaticOrder, true, true>(F.lds, g, S, E, F.tid);
        if (!last && F.bx < 128) {
            pg8::EpiResT<false, true, true> E2;
            E2.xin_lat = nullptr; E2.xin_ctx = nullptr; E2.xbin = (const pg8::bf16_t*)KOUT(); E2.xbout = (pg8::bf16_t*)KOUT();
            E2.gt = modl + 5120; E2.gn = KIN(I_N1G) + (l + 1) * 1024; E2.scn = modl + NSEG * MODW + 1024;
            E2.XM = (pg8::bf16_t*)(F.ws + WS_XM); E2.ssq = (float*)(F.ws + WS_SSQB); E2.row_base = 0;
            pg8::Gemm g2{(const pg8::bf16_t*)(F.ws + WS_Z), (const pg8::bf16_t*)(F.ws + WS_WDN) + (size_t)l * 1024 * FFD, MTOT, 1024, FFD, 128, 128};
            pg8::OneUnit O1; const int e = F.bx >> 2; O1.u.pm = 2 * (MLAT / 256 + (e >> 2)) + ((F.bx >> 1) & 1); O1.u.pn = 2 * (e & 3) + (F.bx & 1);
            int tid_ = F.tid; asm volatile("; quarter-tile unit: lane constants re-derived" : "+v"(tid_));
            pg8::gemm_phase<pg8::EpiResT<false, true, true>, pg8::OneUnit, true, true, true, true>(F.lds, g2, O1, E2, tid_);
        }
        { float* za = (float*)(F.ws + WS_SSQA); for (int i = F.vcu * NTHREADS + F.tid; i < MTOT; i += F.G * NTHREADS) za[i] = 0.f; }
        if (l == 0 && F.bx >= 128) { convert_range(F, 1, 0, CV_ALL, (F.bx - 128) * NWAVES + F.wave, (F.G - 128) * NWAVES); gate_fold(F, 1, (F.bx - 128) * NTHREADS + F.tid, (F.G - 128) * NTHREADS); bias_items(F, 134, 268, F.bx - 128, F.G - 128); }
    }
}
__global__ void __launch_bounds__(NTHREADS, 2) mk_fwd(Args args) {
    extern __shared__ __attribute__((aligned(16))) unsigned char lds_raw[];
    LAS unsigned char* lds0 = (LAS unsigned char*)lds_raw;
    volatile LAS unsigned* MISC = (volatile LAS unsigned*)(lds0 + MISC_OFF);
    for (int u = threadIdx.x; u < (LDS_BYTES - MISC_OFF) / 4; u += NTHREADS) ((LAS unsigned*)(lds0 + MISC_OFF))[u] = 0u;
    __syncthreads();
    const int wave_id = __builtin_amdgcn_readfirstlane(threadIdx.x >> 6);
    XcdBarrier bar = xcd_barrier_post((unsigned*)(args.ws + WS_CTL) + CW_BAR, MISC + 8);
    run_phase<0>(wave_id, lds0, 0);
    run_phase<1>(wave_id, lds0, 0); xcd_barrier(bar, wave_id);
#pragma unroll 1
    for (int l = 0; l < DEPTH; ++l) {
        run_phase<2>(wave_id, lds0, l); xcd_barrier(bar, wave_id);
        run_phase<4>(wave_id, lds0, l); xcd_barrier(bar, wave_id);
        run_phase<5>(wave_id, lds0, l); xcd_barrier(bar, wave_id);
        run_phase<6>(wave_id, lds0, l); xcd_barrier(bar, wave_id);
        run_phase<8>(wave_id, lds0, l); if (l + 1 < DEPTH) xcd_barrier(bar, wave_id);
    }
}

extern "C" void kernel_launch(void* const* d_in, const int* in_sizes, int n_in, void* d_out, int out_size, void* d_ws, size_t ws_size, hipStream_t stream) {
    static int grid = 0;
    if (grid == 0) {
        if (n_in != 20 || out_size != MLAT * 1024 || ws_size < WS_END) { fprintf(stderr, "kernel_launch: unexpected shapes (n_in %d out %d ws %zu); nothing launched\n", n_in, out_size, ws_size); grid = -1; return; }
        int dev = 0, cus = 0;
        if (hipGetDevice(&dev) != hipSuccess || hipDeviceGetAttribute(&cus, hipDeviceAttributeMultiprocessorCount, dev) != hipSuccess) { grid = -1; return; }
        if (hipFuncSetAttribute((const void*)mk_fwd, hipFuncAttributeMaxDynamicSharedMemorySize, LDS_BYTES) != hipSuccess) { fprintf(stderr, "kernel_launch: hipFuncSetAttribute failed\n"); grid = -1; return; }
        (void)hipGetLastError();
        grid = cus;
    }
    if (grid < 0) return;
    (void)hipMemsetAsync((char*)d_ws + WS_CTL, 0, CTL_ZERO_BYTES, stream);
    Args a{};
    for (int i = 0; i < 20; ++i) a.in[i] = (const float*)d_in[i];
    a.out = (float*)d_out; a.ws = (unsigned char*)d_ws;
    hipLaunchKernelGGL(mk_fwd, dim3(grid), dim3(NTHREADS), LDS_BYTES, stream, a);
}
```
